# Optimizing an MI355X kernel written in HIP

```python
import jax, jax.numpy as jnp
from jax import lax
import numpy as np

D_MODEL = 1024
BATCH = 8
SEQ = 4096
DEPTH = 4

N_MIXERS = 3
N_A = (DEPTH + 2) // 3
N_B = (DEPTH + 1) // 3
N_C = DEPTH // 3

ROPE_THETA = 10000.0
RMS_EPS = 1e-6
NEG_INF = -1e30
ADA_INIT_STD = 0.02

MLA_HEADS = 8
MLA_NOPE = 128
MLA_ROPE = 64
MLA_V = 128
MLA_Q_LORA = 256
MLA_KV_LORA = 128
MLA_BLOCK_Q = 128
MLA_WIDTH = MLA_HEADS * MLA_V
MLA_IN = MLA_Q_LORA + MLA_KV_LORA + MLA_ROPE + MLA_WIDTH

SWA_HEADS = 16
SWA_KV_HEADS = 2
SWA_HEAD_DIM = 64
SWA_WINDOW = 128
SWA_BLOCK_Q = 128
SWA_WIDTH = SWA_HEADS * SWA_HEAD_DIM
SWA_KV_W = SWA_KV_HEADS * SWA_HEAD_DIM
SWA_IN = SWA_WIDTH + 2 * SWA_KV_W + SWA_WIDTH

NSA_HEADS = 16
NSA_KV_HEADS = 4
NSA_HEAD_DIM = 64
NSA_CMP_BLOCK = 32
NSA_CMP_STRIDE = 16
NSA_CMP_HIDDEN = 128
NSA_SEL_BLOCK = 64
NSA_N_SELECT = 16
NSA_WINDOW = 512
NSA_BLOCK_Q = 64
NSA_FORCE_BONUS = 1e4
NSA_WIDTH = NSA_HEADS * NSA_HEAD_DIM
NSA_KV_W = NSA_KV_HEADS * NSA_HEAD_DIM
NSA_IN = NSA_WIDTH + 6 * NSA_KV_W + 3 * NSA_HEADS + NSA_WIDTH

kernel_name = 'hybrid_mla_swa_nsa_interleaved'


def rmsnorm(x, g):
    xf = x.astype(jnp.float32)
    y = xf * lax.rsqrt(jnp.mean(xf * xf, axis=-1, keepdims=True) + RMS_EPS)
    return (y * g.astype(jnp.float32)).astype(x.dtype)


def rope(x, positions):
    half = x.shape[-1] // 2
    inv_freq = ROPE_THETA ** (-jnp.arange(half, dtype=jnp.float32) / half)
    ang = positions.astype(jnp.float32)[..., None] * inv_freq
    cos = jnp.cos(ang)[:, :, None, :]
    sin = jnp.sin(ang)[:, :, None, :]
    xf = x.astype(jnp.float32)
    x1, x2 = xf[..., :half], xf[..., half:]
    return jnp.concatenate([x1 * cos - x2 * sin, x2 * cos + x1 * sin], axis=-1).astype(x.dtype)


def dense_causal_attention(q, k, v, block_q):
    B, S, H, dqk = q.shape
    nb = S // block_q
    scale = dqk ** -0.5
    q_blocks = jnp.moveaxis(q.reshape(B, nb, block_q, H, dqk), 1, 0)
    starts = jnp.arange(nb, dtype=jnp.int32) * block_q
    key_pos = jnp.arange(S, dtype=jnp.int32)

    def one_block(args):
        qb, start = args
        s = jnp.einsum('bqhd,bkhd->bhqk', qb, k, preferred_element_type=jnp.float32) * scale
        q_pos = start + jnp.arange(block_q, dtype=jnp.int32)
        s = jnp.where(q_pos[:, None] >= key_pos[None, :], s, NEG_INF)
        p = jax.nn.softmax(s, axis=-1).astype(v.dtype)
        return jnp.einsum('bhqk,bkhd->bqhd', p, v)

    out = lax.map(one_block, (q_blocks, starts))
    return jnp.moveaxis(out, 0, 1).reshape(B, S, H, v.shape[-1])


def banded_attention(q, k, v, window, block_q, sinks=None):
    B, S, KV, G, d = q.shape
    nb = S // block_q
    span = window + block_q
    scale = d ** -0.5
    pad = ((0, 0), (window, 0), (0, 0), (0, 0))
    k_pad = jnp.pad(k, pad)
    v_pad = jnp.pad(v, pad)
    q_blocks = jnp.moveaxis(q.reshape(B, nb, block_q, KV, G, d), 1, 0)
    starts = jnp.arange(nb, dtype=jnp.int32) * block_q

    def one_block(args):
        qb, start = args
        kb = lax.dynamic_slice_in_dim(k_pad, start, span, axis=1)
        vb = lax.dynamic_slice_in_dim(v_pad, start, span, axis=1)
        s = jnp.einsum('bqkgd,bskd->bkgqs', qb, kb, preferred_element_type=jnp.float32) * scale
        q_pos = start + jnp.arange(block_q, dtype=jnp.int32)
        k_pos = start - window + jnp.arange(span, dtype=jnp.int32)
        diff = q_pos[:, None] - k_pos[None, :]
        mask = (diff >= 0) & (diff < window) & (k_pos[None, :] >= 0)
        s = jnp.where(mask, s, NEG_INF)
        if sinks is not None:
            sink = jnp.broadcast_to(sinks.astype(jnp.float32).reshape(KV, G)[None, :, :, None, None],
                                    s.shape[:-1] + (1,))
            p = jax.nn.softmax(jnp.concatenate([s, sink], axis=-1), axis=-1)[..., :-1]
        else:
            p = jax.nn.softmax(s, axis=-1)
        return jnp.einsum('bkgqs,bskd->bqkgd', p.astype(v.dtype), vb)

    out = lax.map(one_block, (q_blocks, starts))
    return jnp.moveaxis(out, 0, 1).reshape(B, S, KV, G, d)


def mla_mixer(h, positions, w_in, q_norm_g, kv_norm_g, w_q_b, w_kv_b, w_out):
    B, S, _ = h.shape
    o1 = MLA_Q_LORA
    o2 = o1 + MLA_KV_LORA
    o3 = o2 + MLA_ROPE
    q_a, kv_a, k_pe, gate = jnp.split(h @ w_in, [o1, o2, o3], axis=-1)
    q = (rmsnorm(q_a, q_norm_g) @ w_q_b).reshape(B, S, MLA_HEADS, MLA_NOPE + MLA_ROPE)
    kv = (rmsnorm(kv_a, kv_norm_g) @ w_kv_b).reshape(B, S, MLA_HEADS, MLA_NOPE + MLA_V)
    q = jnp.concatenate([q[..., :MLA_NOPE], rope(q[..., MLA_NOPE:], positions)], axis=-1)
    k_pe = rope(k_pe[:, :, None, :], positions)
    k = jnp.concatenate([kv[..., :MLA_NOPE],
                         jnp.broadcast_to(k_pe, (B, S, MLA_HEADS, MLA_ROPE))], axis=-1)
    v = kv[..., MLA_NOPE:]
    o = dense_causal_attention(q, k, v, MLA_BLOCK_Q).reshape(B, S, MLA_WIDTH)
    return (o * jax.nn.silu(gate)) @ w_out


def swa_mixer(h, positions, w_in, sinks, w_out):
    B, S, _ = h.shape
    G = SWA_HEADS // SWA_KV_HEADS
    q, k, v, gate = jnp.split(h @ w_in, [SWA_WIDTH, SWA_WIDTH + SWA_KV_W, SWA_WIDTH + 2 * SWA_KV_W], axis=-1)
    q = rope(q.reshape(B, S, SWA_HEADS, SWA_HEAD_DIM), positions).reshape(B, S, SWA_KV_HEADS, G, SWA_HEAD_DIM)
    k = rope(k.reshape(B, S, SWA_KV_HEADS, SWA_HEAD_DIM), positions)
    v = v.reshape(B, S, SWA_KV_HEADS, SWA_HEAD_DIM)
    o = banded_attention(q, k, v, SWA_WINDOW, SWA_BLOCK_Q, sinks).reshape(B, S, SWA_WIDTH)
    return (o * jax.nn.silu(gate)) @ w_out


def compress_blocks(x, pos_emb, w1, w2):
    B, S, KV, d = x.shape
    r = NSA_CMP_BLOCK // NSA_CMP_STRIDE
    n_chunks = S // NSA_CMP_STRIDE
    nc = n_chunks - r + 1
    chunks = x.reshape(B, n_chunks, NSA_CMP_STRIDE, KV, d)
    blocks = jnp.concatenate([chunks[:, i:i + nc] for i in range(r)], axis=2)
    blocks = blocks + pos_emb[None, None, :, None, :]
    flat = jnp.moveaxis(blocks, 3, 2).reshape(B, nc, KV, NSA_CMP_BLOCK * d)
    return jax.nn.silu(flat @ w1) @ w2


def nsa_mixer(h, positions, w_in, cmp_pos, w_cmp_k1, w_cmp_k2, w_cmp_v1, w_cmp_v2, w_out):
    B, S, _ = h.shape
    KV, G, d = NSA_KV_HEADS, NSA_HEADS // NSA_KV_HEADS, NSA_HEAD_DIM
    sizes = [NSA_WIDTH] + [NSA_KV_W] * 6 + [3 * NSA_HEADS]
    splits = [int(s) for s in np.cumsum(sizes)]
    q, k_cmp, v_cmp, k_slc, v_slc, k_win, v_win, g_branch, gate = jnp.split(h @ w_in, splits, axis=-1)
    kv_shape = (B, S, KV, d)
    q = rope(q.reshape(B, S, NSA_HEADS, d), positions).reshape(B, S, KV, G, d)

    k_c = compress_blocks(k_cmp.reshape(kv_shape), cmp_pos, w_cmp_k1, w_cmp_k2)
    v_c = compress_blocks(v_cmp.reshape(kv_shape), cmp_pos, w_cmp_v1, w_cmp_v2)
    nc = k_c.shape[1]
    ns = S // NSA_SEL_BLOCK
    n_top = min(NSA_N_SELECT, ns)
    k_sel = jnp.moveaxis(rope(k_slc.reshape(kv_shape), positions).reshape(B, ns, NSA_SEL_BLOCK, KV, d), 3, 1)
    v_sel = jnp.moveaxis(v_slc.reshape(B, ns, NSA_SEL_BLOCK, KV, d), 3, 1)

    cmp_start = jnp.arange(nc, dtype=jnp.int32) * NSA_CMP_STRIDE
    sel_start = jnp.arange(ns, dtype=jnp.int32) * NSA_SEL_BLOCK
    overlap = jnp.clip(jnp.minimum(cmp_start[:, None] + NSA_CMP_BLOCK, sel_start[None, :] + NSA_SEL_BLOCK)
                       - jnp.maximum(cmp_start[:, None], sel_start[None, :]), 0, None
                       ).astype(jnp.float32) / NSA_CMP_BLOCK
    cmp_end = cmp_start + NSA_CMP_BLOCK - 1
    scale = d ** -0.5
    nb = S // NSA_BLOCK_Q
    q_blocks = jnp.moveaxis(q.reshape(B, nb, NSA_BLOCK_Q, KV, G, d), 1, 0)
    starts = jnp.arange(nb, dtype=jnp.int32) * NSA_BLOCK_Q
    b_idx = jnp.arange(B)[:, None, None, None]
    h_idx = jnp.arange(KV)[None, :, None, None]
    sel_offsets = jnp.arange(NSA_SEL_BLOCK, dtype=jnp.int32)
    blk = jnp.arange(ns, dtype=jnp.int32)

    def one_block(args):
        qb, start = args
        q_pos = start + jnp.arange(NSA_BLOCK_Q, dtype=jnp.int32)
        s_c = jnp.einsum('bqkgd,bnkd->bkgqn', qb, k_c, preferred_element_type=jnp.float32) * scale
        valid_c = cmp_end[None, :] <= q_pos[:, None]
        p_c = jax.nn.softmax(jnp.where(valid_c, s_c, NEG_INF), axis=-1) * valid_c
        o_c = jnp.einsum('bkgqn,bnkd->bqkgd', p_c.astype(v_c.dtype), v_c)
        imp = jnp.einsum('bkgqn,ns->bkqs', p_c, overlap)
        q_blk = q_pos // NSA_SEL_BLOCK
        causal = blk[None, :] <= q_blk[:, None]
        forced = (blk[None, :] == 0) | (blk[None, :] == q_blk[:, None]) | (blk[None, :] == q_blk[:, None] - 1)
        imp = jnp.where(causal, imp + jnp.where(forced, NSA_FORCE_BONUS, 0.0), -1.0)
        _, top_idx = lax.top_k(imp, n_top)
        m = n_top * NSA_SEL_BLOCK
        k_g = k_sel[b_idx, h_idx, top_idx].reshape(B, KV, NSA_BLOCK_Q, m, d)
        v_g = v_sel[b_idx, h_idx, top_idx].reshape(B, KV, NSA_BLOCK_Q, m, d)
        tok = (top_idx[..., None] * NSA_SEL_BLOCK + sel_offsets).reshape(B, KV, NSA_BLOCK_Q, m)
        valid_s = tok <= q_pos[None, None, :, None]
        s_s = jnp.einsum('bqkgd,bkqmd->bkgqm', qb, k_g, preferred_element_type=jnp.float32) * scale
        p_s = jax.nn.softmax(jnp.where(valid_s[:, :, None], s_s, NEG_INF), axis=-1)
        o_s = jnp.einsum('bkgqm,bkqmd->bqkgd', p_s.astype(v_g.dtype), v_g)
        return o_c, o_s

    o_c, o_s = lax.map(one_block, (q_blocks, starts))
    o_c = jnp.moveaxis(o_c, 0, 1).reshape(B, S, KV, G, d)
    o_s = jnp.moveaxis(o_s, 0, 1).reshape(B, S, KV, G, d)
    o_w = banded_attention(q, rope(k_win.reshape(kv_shape), positions), v_win.reshape(kv_shape),
                           NSA_WINDOW, NSA_BLOCK_Q)
    g = jax.nn.sigmoid(g_branch.astype(jnp.float32)).reshape(B, S, KV, G, 3).astype(h.dtype)
    o = g[..., 0:1] * o_c + g[..., 1:2] * o_s + g[..., 2:3] * o_w
    return (o.reshape(B, S, NSA_WIDTH) * jax.nn.silu(gate)) @ w_out


def setup_inputs(seed: int = 0) -> dict:
    key = jax.random.key(seed)
    ks = iter(jax.random.split(key, 32))

    def dense(shape, fan_in):
        return jax.random.normal(next(ks), shape, jnp.float32) * fan_in ** -0.5

    def gain(shape):
        return 1.0 + 0.02 * jax.random.normal(next(ks), shape, jnp.float32)

    x = jax.random.normal(next(ks), (BATCH, SEQ, D_MODEL), jnp.float32)
    c = jax.random.normal(next(ks), (BATCH, D_MODEL), jnp.float32)
    offsets = jax.random.randint(next(ks), (BATCH, 1), 0, 512, dtype=jnp.int32)
    positions = offsets + jnp.arange(SEQ, dtype=jnp.int32)[None, :]
    return {
        'x': x,
        'c': c,
        'positions': positions,
        'norm_g': gain((DEPTH, D_MODEL)),
        'ada_w': ADA_INIT_STD * jax.random.normal(next(ks), (DEPTH, D_MODEL, 3 * D_MODEL), jnp.float32),
        'ada_b': 0.02 * jax.random.normal(next(ks), (DEPTH, 3 * D_MODEL), jnp.float32),
        'mla_w_in': dense((N_A, D_MODEL, MLA_IN), D_MODEL),
        'mla_q_norm_g': gain((N_A, MLA_Q_LORA)),
        'mla_kv_norm_g': gain((N_A, MLA_KV_LORA)),
        'mla_w_q_b': dense((N_A, MLA_Q_LORA, MLA_HEADS * (MLA_NOPE + MLA_ROPE)), MLA_Q_LORA),
        'mla_w_kv_b': dense((N_A, MLA_KV_LORA, MLA_HEADS * (MLA_NOPE + MLA_V)), MLA_KV_LORA),
        'mla_w_out': dense((N_A, MLA_WIDTH, D_MODEL), MLA_WIDTH),
        'swa_w_in': dense((N_B, D_MODEL, SWA_IN), D_MODEL),
        'swa_sinks': jax.random.normal(next(ks), (N_B, SWA_HEADS), jnp.float32),
        'swa_w_out': dense((N_B, SWA_WIDTH, D_MODEL), SWA_WIDTH),
        'nsa_w_in': dense((N_C, D_MODEL, NSA_IN), D_MODEL),
        'nsa_cmp_pos': 0.1 * jax.random.normal(next(ks), (N_C, NSA_CMP_BLOCK, NSA_HEAD_DIM), jnp.float32),
        'nsa_w_cmp_k1': dense((N_C, NSA_CMP_BLOCK * NSA_HEAD_DIM, NSA_CMP_HIDDEN), NSA_CMP_BLOCK * NSA_HEAD_DIM),
        'nsa_w_cmp_k2': dense((N_C, NSA_CMP_HIDDEN, NSA_HEAD_DIM), NSA_CMP_HIDDEN),
        'nsa_w_cmp_v1': dense((N_C, NSA_CMP_BLOCK * NSA_HEAD_DIM, NSA_CMP_HIDDEN), NSA_CMP_BLOCK * NSA_HEAD_DIM),
        'nsa_w_cmp_v2': dense((N_C, NSA_CMP_HIDDEN, NSA_HEAD_DIM), NSA_CMP_HIDDEN),
        'nsa_w_out': dense((N_C, NSA_WIDTH, D_MODEL), NSA_WIDTH),
        'final_norm_g': gain((D_MODEL,)),
    }


def reference(x, c, positions, norm_g, ada_w, ada_b,
              mla_w_in, mla_q_norm_g, mla_kv_norm_g, mla_w_q_b, mla_w_kv_b, mla_w_out,
              swa_w_in, swa_sinks, swa_w_out,
              nsa_w_in, nsa_cmp_pos, nsa_w_cmp_k1, nsa_w_cmp_k2, nsa_w_cmp_v1, nsa_w_cmp_v2, nsa_w_out,
              final_norm_g):
    cond = jax.nn.silu(c)
    for i in range(DEPTH):
        shift, scale, gate = jnp.split(cond @ ada_w[i] + ada_b[i], 3, axis=-1)
        h = rmsnorm(x, norm_g[i]) * (1 + scale[:, None, :]) + shift[:, None, :]
        kind, j = i % N_MIXERS, i // N_MIXERS
        if kind == 0:
            y = mla_mixer(h, positions, mla_w_in[j], mla_q_norm_g[j], mla_kv_norm_g[j],
                          mla_w_q_b[j], mla_w_kv_b[j], mla_w_out[j])
        elif kind == 1:
            y = swa_mixer(h, positions, swa_w_in[j], swa_sinks[j], swa_w_out[j])
        else:
            y = nsa_mixer(h, positions, nsa_w_in[j], nsa_cmp_pos[j], nsa_w_cmp_k1[j], nsa_w_cmp_k2[j],
                          nsa_w_cmp_v1[j], nsa_w_cmp_v2[j], nsa_w_out[j])
        x = x + gate[:, None, :] * y
    return rmsnorm(x, final_norm_g)
```

```cpp
#include <hip/hip_runtime.h>
#include <hip/hip_cooperative_groups.h>
#include <stdint.h>
#include <cstdio>
namespace cg = cooperative_groups;

#define DI __device__ __forceinline__
typedef __bf16 bf16;
typedef __bf16 bf16x8 __attribute__((ext_vector_type(8)));
typedef __bf16 bf16x4 __attribute__((ext_vector_type(4)));
typedef __bf16 bf16x2 __attribute__((ext_vector_type(2)));
typedef float f32x16 __attribute__((ext_vector_type(16)));
typedef float f32x4 __attribute__((ext_vector_type(4)));
typedef float f32x2 __attribute__((ext_vector_type(2)));
typedef short s16x4 __attribute__((ext_vector_type(4)));
typedef short s16x8 __attribute__((ext_vector_type(8)));
typedef unsigned u32x4 __attribute__((ext_vector_type(4)));

constexpr int T = 32768, S = 4096;
constexpr float LOG2E = 1.4426950408889634f;
constexpr int NT = 512, NW = 8;
constexpr int SMEM_BYTES = 2 * 2 * 256 * 72 * 2 + 1024;

struct Params {
  const float *x, *c; const int* pos; const float *norm_g, *ada_w, *ada_b;
  const float *mla_w_in, *mla_qg, *mla_kvg, *mla_wqb, *mla_wkvb, *mla_wout;
  const float *swa_w_in, *swa_sinks, *swa_wout;
  const float *nsa_w_in, *nsa_pos, *nsa_k1, *nsa_k2, *nsa_v1, *nsa_v2, *nsa_wout;
  const float *final_g;
  float* out;
  bf16 *wt_mla_in[2], *wt_mla_qb[2], *wt_mla_kvb[2], *wt_mla_out[2];
  bf16 *wt_swa_in, *wt_swa_out, *wt_nsa_in, *wt_nsa_k1, *wt_nsa_k2, *wt_nsa_v1, *wt_nsa_v2, *wt_nsa_out;
  float* mod;
  float2* rope;
  float* posbp;
  bf16 *h, *sg;
  bf16 *qa, *kva, *Qm, *Km, *Vm;
  bf16 *Qs, *Ks, *Vs;
  bf16 *kcmp, *vcmp, *kslc, *vslc, *kwin, *vwin, *gb, *hidk, *hidv, *kc, *vc;
  uint64_t* selmask;
  unsigned* bar;
  float *ssq_q, *ssq_kv;
};

DI f32x16 mfma32(bf16x8 a, bf16x8 b, f32x16 c) { return __builtin_amdgcn_mfma_f32_32x32x16_bf16(a, b, c, 0, 0, 0); }
DI int crow(int i, int h) { return (i & 3) + 8 * (i >> 2) + 4 * h; }
DI float fexp2(float x) { return __builtin_amdgcn_exp2f(x); }
DI float silu_f(float v) { return v * __builtin_amdgcn_rcpf(1.f + __expf(-v)); }
DI bf16 tobf(float v) { return (bf16)v; }
DI int tid_(const int wv) { int l = __builtin_amdgcn_mbcnt_hi(~0u, __builtin_amdgcn_mbcnt_lo(~0u, 0u)); asm volatile("" : "+v"(l)); return wv * 64 + l; }
#define tid() tid_(wv)
DI int vblock() {
  const int g = gridDim.x, b = blockIdx.x;
  return ((g & 7) == 0) ? (b & 7) * (g >> 3) + (b >> 3) : b;
}

constexpr int GEMM_BUFE = 2 * 256 * 72;
struct NoPre { DI void operator()(int) const {} };
template <bool F32OUT, class AF, class MATH, class STORE, class PRE>
DI void gemm_run(const int wv, AF af, const bf16* __restrict__ Bt, int K, int M, int ntn, int tl0, int tstride, int ntiles, MATH emath, STORE estore, PRE pre, char* smem) {
  bf16* sbase = (bf16*)smem;
  const int t = tid(), lane = t & 63, wave = __builtin_amdgcn_readfirstlane(t >> 6), r = lane & 31, h = lane >> 5;
  const int wm = wave >> 1, wn = wave & 1;
  const int lrow = t >> 3, lkc = (t & 7) * 8;
  const int nk = K >> 6;
  u32x4 ra[4], rb[4];
  auto issue = [&](int tl, int ks) {
    const int mt = tl / ntn, n_t = tl - mt * ntn;
#pragma unroll
    for (int i = 0; i < 4; ++i) {
      const int row = lrow + 64 * i;
      int gm = mt * 256 + row; gm = gm < M ? gm : M - 1;
      ra[i] = *(const u32x4*)(af(gm, ks * 64 + lkc));
      rb[i] = *(const u32x4*)(Bt + (size_t)(n_t * 256 + row) * K + ks * 64 + lkc);
    }
  };
  if (tl0 < ntiles) issue(tl0, 0);
  for (int tl = tl0; tl < ntiles; tl += tstride) {
    const int mt = tl / ntn, n_t = tl - mt * ntn;
    const int m0 = mt * 256, n0 = n_t * 256;
    pre(m0);
    f32x16 acc[2][4];
#pragma unroll
    for (int a = 0; a < 2; ++a)
#pragma unroll
      for (int b = 0; b < 4; ++b)
#pragma unroll
        for (int i = 0; i < 16; ++i) acc[a][b][i] = 0.f;
    for (int s = 0; s < nk; ++s) {
      bf16* sA = sbase + (s & 1) * GEMM_BUFE;
      bf16* sB = sA + 256 * 72;
      int lro = lrow * 72 + lkc; asm volatile("" : "+v"(lro));
#pragma unroll
      for (int i = 0; i < 4; ++i) {
        *(u32x4*)(sA + lro + 64 * 72 * i) = ra[i];
        *(u32x4*)(sB + lro + 64 * 72 * i) = rb[i];
      }
      if (s + 1 < nk) issue(tl, s + 1);
      else if (tl + tstride < ntiles) issue(tl + tstride, 0);
      __syncthreads();
#pragma unroll
      for (int ks = 0; ks < 4; ++ks) {
        bf16x8 a0 = *(const bf16x8*)(sA + (wm * 64 + r) * 72 + ks * 16 + h * 8);
        bf16x8 a1 = *(const bf16x8*)(sA + (wm * 64 + 32 + r) * 72 + ks * 16 + h * 8);
#pragma unroll
        for (int nt = 0; nt < 4; ++nt) {
          bf16x8 bq = *(const bf16x8*)(sB + (wn * 128 + nt * 32 + r) * 72 + ks * 16 + h * 8);
          acc[0][nt] = mfma32(a0, bq, acc[0][nt]);
          acc[1][nt] = mfma32(a1, bq, acc[1][nt]);
        }
      }
      __builtin_amdgcn_sched_group_barrier(0x100, 6, 0);
#pragma unroll
      for (int g = 0; g < 3; ++g) {
        __builtin_amdgcn_sched_group_barrier(0x008, 2, 0); __builtin_amdgcn_sched_group_barrier(0x100, 2, 0);
        __builtin_amdgcn_sched_group_barrier(0x008, 2, 0); __builtin_amdgcn_sched_group_barrier(0x100, 2, 0);
        __builtin_amdgcn_sched_group_barrier(0x008, 2, 0); __builtin_amdgcn_sched_group_barrier(0x100, 2, 0);
        __builtin_amdgcn_sched_group_barrier(0x008, 2, 0);
      }
      __builtin_amdgcn_sched_group_barrier(0x008, 8, 0);
    }
    __syncthreads();
    {
      int el = lane; asm volatile("" : "+v"(el));
      const int er = el & 31, eh = el >> 5;
      char* ebase = (char*)(sbase + GEMM_BUFE) + wave * (F32OUT ? 32 * 68 * 4 : 32 * 72 * 2);
      char* ewr = ebase + (F32OUT ? (4 * eh * 68 + er) * 4 : (4 * eh * 72 + er) * 2);
      const char* erd = ebase + (F32OUT ? ((el >> 4) * 68 + (el & 15) * 4) * 4 : ((el >> 3) * 72 + (el & 7) * 8) * 2);
      const int rd_row = F32OUT ? (el >> 4) : (el >> 3), rd_c = F32OUT ? (el & 15) : (el & 7);
#pragma unroll
      for (int mt2 = 0; mt2 < 2; ++mt2)
#pragma unroll
        for (int np = 0; np < 2; ++np) {
          const int col0 = n0 + wn * 128 + np * 64;
          const int rowb = m0 + wm * 64 + mt2 * 32;
#pragma unroll
          for (int i = 0; i < 16; ++i) {
            const int rlc = (i & 3) + 8 * (i >> 2);
            int row = rowb + rlc + 4 * eh; row = row < M ? row : M - 1;
            float v0 = acc[mt2][2 * np][i], v1 = acc[mt2][2 * np + 1][i];
            emath(row, col0 + er, v0, v1);
            if (F32OUT) { float* e = (float*)ewr; e[rlc * 68] = v0; e[rlc * 68 + 32] = v1; }
            else { bf16* e = (bf16*)ewr; e[rlc * 72] = tobf(v0); e[rlc * 72 + 32] = tobf(v1); }
          }
          if (F32OUT) {
#pragma unroll
            for (int k = 0; k < 8; ++k) {
              u32x4 d = *(const u32x4*)((const float*)erd + 4 * k * 68);
              if (rowb + rd_row + 4 * k < M) estore(rowb + rd_row + 4 * k, col0, rd_c, d);
            }
          } else {
#pragma unroll
            for (int k = 0; k < 4; ++k) {
              u32x4 d = *(const u32x4*)((const bf16*)erd + 8 * k * 72);
              if (rowb + rd_row + 8 * k < M) estore(rowb + rd_row + 8 * k, col0, rd_c, d);
            }
          }
        }
    }
  }
}

struct APlain {
  const bf16* A; int lda;
  DI const bf16* operator()(int row, int k) const { return A + (size_t)row * lda + k; }
};
struct ACmp {
  const bf16* src;
  DI const bf16* operator()(int row, int k) const {
    int kvh = row & 3, bn = row >> 2, b = bn / 255, n = bn - b * 255;
    return src + ((size_t)(b * 4096 + 16 * n + (k >> 6)) * 256 + kvh * 64) + (k & 63);
  }
};

enum { M_CAUSAL = 0, M_WINDOW = 1, M_CMP = 2, M_SEL = 3 };

template <int DQK, int DV, int MODE, int KT>
DI void attn_core(const int wv, const bf16x8 (&qf)[DQK / 16], const bf16* __restrict__ Kp, int ldk, const bf16* __restrict__ Vp, int ldv,
                  int q0, int qspan, int qw, int W, uint64_t selm, f32x16 (&ot)[DV / 32], float& m_out, float& l_out, char* smem) {
  constexpr int KS = DQK + 8, VS = DV + 32;
  constexpr int KCH = DQK / 8, VCH = DV / 8;
  constexpr int NKL = (KT * KCH + NT - 1) / NT, NVL = (KT * VCH + NT - 1) / NT;
  constexpr bool KPART = (KT * KCH) % NT != 0, VPART = (KT * VCH) % NT != 0;
  constexpr int NS = KT / 32;
  constexpr bool KLIN = (KCH & (KCH - 1)) != 0;
  constexpr int STG = KT * KS + KT * VS;
  bf16* const sbase = (bf16*)smem;
  const int t = tid(), lane = t & 63, wave = __builtin_amdgcn_readfirstlane(t >> 6), r = lane & 31, h = lane >> 5;
  const int qpos = qw + r;
  int kt_begin = 0, kt_end;
  if (MODE == M_WINDOW) { int s0 = q0 - W + 1; kt_begin = (s0 > 0 ? s0 : 0) / KT; }
  if (MODE == M_CMP) { int nmax = (q0 + qspan - 32) >> 4; nmax = nmax < 254 ? nmax : 254; kt_end = nmax / KT + 1; }
  else kt_end = (q0 + qspan + KT - 1) / KT;

#pragma unroll
  for (int d = 0; d < DV / 32; ++d)
#pragma unroll
    for (int i = 0; i < 16; ++i) ot[d][i] = 0.f;
  float m = -1e30f, l = 0.f;

  u32x4 rk[NKL], rv[NVL];
  const int krow0 = KLIN ? 0 : t / KCH, kcol0 = KLIN ? 0 : (t % KCH) * 8;
  const bf16* kgl = KLIN ? (Kp + t * 8) : (Kp + (size_t)krow0 * ldk + kcol0);
  const int vrow0 = t / VCH, vcol0 = (t % VCH) * 8;
  const bf16* vgl = Vp + (size_t)vrow0 * ldv + vcol0;
  auto gloadK = [&](int kt) {
    const bf16* kb = kgl + (size_t)(kt * KT) * ldk;
#pragma unroll
    for (int i = 0; i < NKL; ++i) if (!KPART || t + NT * i < KT * KCH) rk[i] = *(const u32x4*)(kb + (KLIN ? (size_t)i * (NT * 8) : (size_t)i * (NT / KCH) * ldk));
  };
  auto gloadV = [&](int kt) {
    const bf16* vb = vgl + (size_t)(kt * KT) * ldv;
#pragma unroll
    for (int i = 0; i < NVL; ++i) if (!VPART || t + NT * i < KT * VCH) rv[i] = *(const u32x4*)(vb + (size_t)i * (NT / VCH) * ldv);
  };
  gloadK(kt_begin); gloadV(kt_begin);
  const int i16 = lane & 15;
  const int vtr_off = KT * KS + (4 * h + (i16 >> 2)) * VS + 16 * ((lane >> 4) & 1) + 4 * (i16 & 3);
  __syncthreads();

  int ka = kt_begin, kb;
  if (MODE == M_CAUSAL) kb = (qw + 31) / KT + 1;
  else if (MODE == M_WINDOW) { int lo = qw - W + 1; lo = lo > 0 ? lo / KT : 0; ka = lo > kt_begin ? lo : kt_begin; kb = (qw + 31) / KT + 1; }
  else if (MODE == M_CMP) kb = qw / (16 * KT) + 1;
  else kb = (qw >> 6) + 1;
  kb = kb < kt_end ? kb : kt_end;
  kb = kb > ka ? kb : ka;
  auto advance = [&](int kt) {
    bf16* const sK = sbase + ((kt - kt_begin) & 1) * STG;
    bf16* const sV = sK + KT * KS;
#pragma unroll
    for (int i = 0; i < NKL; ++i) {
      if (!KPART || t + NT * i < KT * KCH) {
        if (KLIN) { int c = t + NT * i; int row = c / KCH, kc = c - row * KCH; *(u32x4*)(sK + row * KS + kc * 8) = rk[i]; }
        else *(u32x4*)(sK + (krow0 + i * (NT / KCH)) * KS + kcol0) = rk[i];
      }
    }
#pragma unroll
    for (int i = 0; i < NVL; ++i) if (!VPART || t + NT * i < KT * VCH) *(u32x4*)(sV + (vrow0 + i * (NT / VCH)) * VS + vcol0) = rv[i];
    if (kt + 1 < kt_end) { gloadK(kt + 1); gloadV(kt + 1); }
    __syncthreads();
  };
  for (int kt = kt_begin; kt < ka; ++kt) advance(kt);
  for (int kt = ka; kt < kb; ++kt) {
    advance(kt);
    bf16* const sK = sbase + ((kt - kt_begin) & 1) * STG;
    const bf16* const vtr = sK + vtr_off;
    const int k0 = kt * KT;
    bool needmask;
    if (MODE == M_CAUSAL) needmask = k0 + KT - 1 > qw;
    else if (MODE == M_WINDOW) needmask = !((k0 + KT - 1 <= qw) && (k0 >= qw + 32 - W));
    else needmask = true;

    f32x16 st[NS];
#pragma unroll
    for (int a = 0; a < NS; ++a)
#pragma unroll
      for (int i = 0; i < 16; ++i) st[a][i] = 0.f;
#pragma unroll
    for (int ks = 0; ks < DQK / 16; ++ks) {
#pragma unroll
      for (int a = 0; a < NS; ++a) {
        bf16x8 af_ = *(const bf16x8*)(sK + (32 * a + r) * KS + ks * 16 + h * 8);
        st[a] = mfma32(af_, qf[ks], st[a]);
      }
    }
    const bool selbit = (MODE == M_SEL) ? ((selm >> (k0 >> 6)) & 1ull) != 0 : true;
    const bool emask = (MODE == M_SEL) ? (k0 + KT - 1 > qw) : needmask;
    if (emask) {
#pragma unroll
      for (int a = 0; a < NS; ++a)
#pragma unroll
        for (int i = 0; i < 16; ++i) {
          const int kpos = k0 + 32 * a + crow(i, h);
          bool ok;
          if (MODE == M_CAUSAL) ok = kpos <= qpos;
          else if (MODE == M_WINDOW) ok = (kpos <= qpos) && (kpos + W > qpos);
          else if (MODE == M_CMP) ok = (16 * kpos + 31 <= qpos) && (kpos <= 254);
          else ok = kpos <= qpos;
          st[a][i] = ok ? st[a][i] : -INFINITY;
        }
    }
    float tmax = -INFINITY;
#pragma unroll
    for (int a = 0; a < NS; ++a)
#pragma unroll
      for (int i = 0; i < 16; ++i) tmax = fmaxf(tmax, st[a][i]);
    tmax = fmaxf(tmax, __shfl_xor(tmax, 32));
    if (MODE == M_SEL) tmax = selbit ? tmax : -INFINITY;
    if (__any(tmax > m + 8.f)) {
      const float mnew = fmaxf(m, tmax);
      const float alpha = fexp2(m - mnew);
      m = mnew;
      l *= alpha;
#pragma unroll
      for (int d = 0; d < DV / 32; ++d)
#pragma unroll
        for (int i = 0; i < 16; ++i) ot[d][i] *= alpha;
    }
    const float ms = (MODE == M_SEL && !selbit) ? INFINITY : m;
    float ls = 0.f;
#pragma unroll
    for (int a = 0; a < NS; ++a)
#pragma unroll
      for (int i = 0; i < 16; ++i) { float pv = fexp2(st[a][i] - ms); st[a][i] = pv; ls += pv; }
    l += ls;
#pragma unroll
    for (int kk = 0; kk < 2 * NS; ++kk) {
      bf16x8 pf;
#pragma unroll
      for (int j = 0; j < 8; ++j) pf[j] = (bf16)st[kk >> 1][8 * (kk & 1) + j];
#pragma unroll
      for (int d = 0; d < DV / 32; ++d) {
        s16x4 lo = __builtin_amdgcn_ds_read_tr16_b64_v4i16((__attribute__((address_space(3))) s16x4*)(vtr + (16 * kk) * VS + 32 * d));
        s16x4 hi = __builtin_amdgcn_ds_read_tr16_b64_v4i16((__attribute__((address_space(3))) s16x4*)(vtr + (16 * kk + 8) * VS + 32 * d));
        s16x8 v8 = __builtin_shufflevector(lo, hi, 0, 1, 2, 3, 4, 5, 6, 7);
        ot[d] = mfma32(__builtin_bit_cast(bf16x8, v8), pf, ot[d]);
      }
    }
  }
  for (int kt = kb; kt < kt_end; ++kt) advance(kt);
  l_out = l + __shfl_xor(l, 32);
  m_out = m;
}

constexpr int ATT_EPI_OFF = 96 * 1024;
template <int DV>
DI void attn_store(const int wv, const f32x16 (&ot)[DV / 32], float scale, const bf16* __restrict__ sg, bf16* __restrict__ out,
                   size_t tok0, int col0, char* smem) {
  const int t = tid(), lane = t & 63, wave = __builtin_amdgcn_readfirstlane(t >> 6), r = lane & 31, h = lane >> 5;
  bf16* e = (bf16*)(smem + ATT_EPI_OFF + wave * (32 * 72 * 2));
#pragma unroll
  for (int hf = 0; hf < DV / 64; ++hf) {
#pragma unroll
    for (int dd = 0; dd < 2; ++dd)
#pragma unroll
      for (int g = 0; g < 4; ++g) {
        bf16x4 o;
#pragma unroll
        for (int k = 0; k < 4; ++k) o[k] = tobf(ot[2 * hf + dd][4 * g + k] * scale);
        *(bf16x4*)(e + r * 72 + 32 * dd + 8 * g + 4 * h) = o;
      }
#pragma unroll
    for (int k = 0; k < 4; ++k) {
      const int rl = (lane >> 3) + 8 * k, c = lane & 7;
      const bf16x8 ov = *(const bf16x8*)(e + rl * 72 + c * 8);
      const size_t off = (tok0 + rl) * 1024 + col0 + 64 * hf + c * 8;
      const bf16x8 gv = *(const bf16x8*)(sg + off);
      bf16x8 res;
#pragma unroll
      for (int q = 0; q < 8; ++q) res[q] = tobf((float)ov[q] * (float)gv[q]);
      *(bf16x8*)(out + off) = res;
    }
  }
}

DI void prep_transpose(const int wv, const float* __restrict__ W, int K, int N, int Npad, bf16* __restrict__ dst, const float* __restrict__ kscale, int perm, char* smem) {
  float* tile = (float*)smem;
  const int t = tid();
  const int ntk = K / 64, ntn = Npad / 64;
  for (int tl = vblock(); tl < ntk * ntn; tl += gridDim.x) {
    const int tn = tl / ntk, tk = tl - tn * ntk;
    __syncthreads();
#pragma unroll
    for (int i = 0; i < 64 / NW; ++i) {
      int kk = i * NW + (t >> 6), nn = t & 63;
      int j = tn * 64 + nn;
      int src = j;
      if (perm) { src = (j < 2560) ? j : (j < 3584 ? j + 48 : j - 1024); }
      float v = 0.f;
      if (j < N) { v = W[(size_t)(tk * 64 + kk) * N + src]; if (kscale) v *= kscale[tk * 64 + kk]; }
      tile[kk * 65 + nn] = v;
    }
    __syncthreads();
#pragma unroll
    for (int i = 0; i < 64 / NW; ++i) {
      int nn = i * NW + (t >> 6), kk = t & 63;
      dst[(size_t)(tn * 64 + nn) * K + tk * 64 + kk] = tobf(tile[kk * 65 + nn]);
    }
  }
}

DI void phase_prep(const int wv, const Params& p, char* smem) {
  const int t = tid();
  const float invf = (float)pow(10000.0, -(double)(t & 31) / 32.0);
  for (int i = blockIdx.x * NT + t; i < T * 32; i += gridDim.x * NT) {
    int tok = i >> 5;
    float ang = (float)p.pos[tok] * invf;
    float sn, cs; sincosf(ang, &sn, &cs);
    p.rope[i] = make_float2(cs, sn);
  }
  {
    float* cond = (float*)smem;
    float* red = cond + 8192;
    for (int task = gridDim.x - 1 - blockIdx.x; task < 192; task += gridDim.x) {
      __syncthreads();
      for (int i = t; i < 8192; i += NT) cond[i] = silu_f(p.c[i]);
      __syncthreads();
      const int layer = task / 48, cg_ = task % 48, lane = t & 63, wave = t >> 6;
      const int col = cg_ * 64 + lane;
      const float* w = p.ada_w + (size_t)layer * 1024 * 3072 + col;
      float acc[8];
#pragma unroll
      for (int b = 0; b < 8; ++b) acc[b] = 0.f;
      for (int k = wave * (1024 / NW); k < (wave + 1) * (1024 / NW); k += 16) {
        float wq[16];
#pragma unroll
        for (int u = 0; u < 16; ++u) wq[u] = w[(size_t)(k + u) * 3072];
#pragma unroll
        for (int u = 0; u < 16; ++u)
#pragma unroll
          for (int b = 0; b < 8; ++b) acc[b] += cond[b * 1024 + k + u] * wq[u];
      }
#pragma unroll
      for (int b = 0; b < 8; ++b) red[(wave * 8 + b) * 64 + lane] = acc[b];
      __syncthreads();
      for (int i = t; i < 512; i += NT) {
        int b = i >> 6, ln = i & 63;
        float s = 0.f;
#pragma unroll
        for (int w = 0; w < NW; ++w) s += red[(w * 8 + b) * 64 + ln];
        int cc = cg_ * 64 + ln;
        p.mod[((size_t)layer * 8 + b) * 3072 + cc] = s + p.ada_b[layer * 3072 + cc];
      }
    }
  }
}

DI void phase_prep_b(const int wv, const Params& p, char* smem) {
  const int t = tid();
  {
    for (int task = blockIdx.x; task < 32; task += gridDim.x) {
      const int which = task >> 4, kcid = task & 15;
      const float* w1 = which ? p.nsa_v1 : p.nsa_k1;
      __syncthreads();
      const int col = t & 127, part = t >> 7;
      constexpr int RPG = 128 / (NT / 128);
      float s = 0.f;
      for (int k = kcid * 128 + part * RPG; k < kcid * 128 + (part + 1) * RPG; ++k) s += p.nsa_pos[k] * w1[(size_t)k * 128 + col];
      float* red2 = (float*)smem;
      red2[t] = s;
      __syncthreads();
      if (t < 128) { float a = 0.f; for (int q = 0; q < NT / 128; ++q) a += red2[t + 128 * q]; p.posbp[(which * 16 + kcid) * 128 + t] = a; }
    }
  }
  for (int j = 0; j < 2; ++j) {
    prep_transpose(wv, p.mla_w_in + (size_t)j * 1024 * 1472, 1024, 1472, 1536, p.wt_mla_in[j], nullptr, 0, smem);
    prep_transpose(wv, p.mla_wqb + (size_t)j * 256 * 1536, 256, 1536, 1536, p.wt_mla_qb[j], p.mla_qg + j * 256, 0, smem);
    prep_transpose(wv, p.mla_wkvb + (size_t)j * 128 * 2048, 128, 2048, 2048, p.wt_mla_kvb[j], p.mla_kvg + j * 128, 0, smem);
    prep_transpose(wv, p.mla_wout + (size_t)j * 1024 * 1024, 1024, 1024, 1024, p.wt_mla_out[j], nullptr, 0, smem);
  }
  prep_transpose(wv, p.swa_w_in, 1024, 2304, 2304, p.wt_swa_in, nullptr, 0, smem);
  prep_transpose(wv, p.swa_wout, 1024, 1024, 1024, p.wt_swa_out, nullptr, 0, smem);
  prep_transpose(wv, p.nsa_w_in, 1024, 3632, 3840, p.wt_nsa_in, nullptr, 1, smem);
  prep_transpose(wv, p.nsa_k1, 2048, 128, 256, p.wt_nsa_k1, nullptr, 0, smem);
  prep_transpose(wv, p.nsa_k2, 128, 64, 256, p.wt_nsa_k2, nullptr, 0, smem);
  prep_transpose(wv, p.nsa_v1, 2048, 128, 256, p.wt_nsa_v1, nullptr, 0, smem);
  prep_transpose(wv, p.nsa_v2, 128, 64, 256, p.wt_nsa_v2, nullptr, 0, smem);
  prep_transpose(wv, p.nsa_wout, 1024, 1024, 1024, p.wt_nsa_out, nullptr, 0, smem);
}

DI void phase_norm(const int wv, const Params& p, int layer, const float* __restrict__ xin) {
  const int lane = tid() & 63, wave = tid() >> 6;
  const float* g = p.norm_g + layer * 1024;
  for (int row = blockIdx.x * NW + wave; row < T; row += gridDim.x * NW) {
    const int b = row >> 12;
    const float* md = p.mod + ((size_t)layer * 8 + b) * 3072;
    const float4* xr = (const float4*)(xin + (size_t)row * 1024);
    float4 v[4]; float s = 0.f;
#pragma unroll
    for (int i = 0; i < 4; ++i) { v[i] = xr[lane + 64 * i]; s += v[i].x * v[i].x + v[i].y * v[i].y + v[i].z * v[i].z + v[i].w * v[i].w; }
#pragma unroll
    for (int o = 32; o > 0; o >>= 1) s += __shfl_xor(s, o);
    const float rs = rsqrtf(s * (1.f / 1024.f) + 1e-6f);
    if (lane == 0) { p.ssq_q[row] = 0.f; p.ssq_kv[row] = 0.f; }
#pragma unroll
    for (int i = 0; i < 4; ++i) {
      const int c = (lane + 64 * i) * 4;
      float4 gg = *(const float4*)(g + c), sh = *(const float4*)(md + c), sc = *(const float4*)(md + 1024 + c);
      bf16x4 o;
      o[0] = tobf(v[i].x * rs * gg.x * (1.f + sc.x) + sh.x);
      o[1] = tobf(v[i].y * rs * gg.y * (1.f + sc.y) + sh.y);
      o[2] = tobf(v[i].z * rs * gg.z * (1.f + sc.z) + sh.z);
      o[3] = tobf(v[i].w * rs * gg.w * (1.f + sc.w) + sh.w);
      *(bf16x4*)(p.h + (size_t)row * 1024 + c) = o;
    }
  }
}

DI void phase_final(const int wv, const Params& p) {
  const int lane = tid() & 63, wave = tid() >> 6;
  for (int row = blockIdx.x * NW + wave; row < T; row += gridDim.x * NW) {
    float4* xr = (float4*)(p.out + (size_t)row * 1024);
    float4 v[4]; float s = 0.f;
#pragma unroll
    for (int i = 0; i < 4; ++i) { v[i] = xr[lane + 64 * i]; s += v[i].x * v[i].x + v[i].y * v[i].y + v[i].z * v[i].z + v[i].w * v[i].w; }
#pragma unroll
    for (int o = 32; o > 0; o >>= 1) s += __shfl_xor(s, o);
    const float rs = rsqrtf(s * (1.f / 1024.f) + 1e-6f);
#pragma unroll
    for (int i = 0; i < 4; ++i) {
      float4 gg = *(const float4*)(p.final_g + (lane + 64 * i) * 4);
      xr[lane + 64 * i] = make_float4(v[i].x * rs * gg.x, v[i].y * rs * gg.y, v[i].z * rs * gg.z, v[i].w * rs * gg.w);
    }
  }
}

DI void rope_pair(const Params& p, int row, int f, float v0, float v1, float& o0, float& o1) {
  float2 cs = p.rope[(size_t)row * 32 + f];
  o0 = v0 * cs.x - v1 * cs.y;
  o1 = v1 * cs.x + v0 * cs.y;
}

template <bool F32OUT, class AF, class MATH, class STORE>
DI void gemm_phase(const int wv, AF af, const bf16* Bt, int K, int M, int Npad, MATH emath, STORE estore, char* smem, int tile_off) {
  const int ntn = Npad / 256, ntm = (M + 255) / 256, nt = ntn * ntm;
  int first = vblock() - (tile_off % (int)gridDim.x);
  if (first < 0) first += gridDim.x;
  gemm_run<F32OUT>(wv, af, Bt, K, M, ntn, first, (int)gridDim.x, nt, emath, estore, NoPre(), smem);
}
DI void st16(bf16* dst, u32x4 d) { *(u32x4*)dst = d; }

DI void phase_mla_inproj(const int wv, const Params& p, int j, char* smem) {
  APlain af{p.h, 1024};
  auto emath = [&](int row, int col, float& v0, float& v1) {
    const int cs = col >> 6;
    if (cs == 6) { float o0, o1; rope_pair(p, row, col - 384, v0, v1, o0, o1); v0 = o0; v1 = o1; }
    else if (cs >= 7) { v0 = silu_f(v0); v1 = silu_f(v1); }
  };
  auto estore = [&](int row, int col0, int c, u32x4 d) {
    const int cs = col0 >> 6;
    if (cs < 6) {
      const bf16x8 dv = __builtin_bit_cast(bf16x8, d);
      float sq = 0.f;
#pragma unroll
      for (int e = 0; e < 8; ++e) { const float f = (float)dv[e]; sq += f * f; }
      sq += __shfl_xor(sq, 1); sq += __shfl_xor(sq, 2); sq += __shfl_xor(sq, 4);
      if (cs < 4) { st16(p.qa + (size_t)row * 256 + col0 + 8 * c, d); if (c == 0) atomicAdd(p.ssq_q + row, sq); }
      else { st16(p.kva + (size_t)row * 128 + (col0 - 256) + 8 * c, d); if (c == 0) atomicAdd(p.ssq_kv + row, sq); }
    }
    else if (cs == 6) {
      const int b = row >> 12, s = row & 4095;
      bf16* kr = p.Km + ((size_t)(b * 8) * 4096 + s) * 192 + 128 + 8 * c;
#pragma unroll 1
      for (int hd = 0; hd < 8; ++hd) { st16(kr, d); kr += (size_t)4096 * 192; }
    } else if (cs < 23) st16(p.sg + (size_t)row * 1024 + (col0 - 448) + 8 * c, d);
  };
  gemm_phase<false>(wv, af, p.wt_mla_in[j], 1024, T, 1536, emath, estore, smem, 0);
}

DI void phase_mla_qkvb(const int wv, const Params& p, int j, char* smem) {
  {
    const float qscale = 0.07216878364870322f * LOG2E;
    APlain af{p.qa, 256};
    auto emath = [&](int row, int col, float& v0, float& v1) {
      const float rs = rsqrtf(p.ssq_q[row] * (1.f / 256.f) + 1e-6f) * qscale;
      v0 *= rs; v1 *= rs;
      const int cs = col >> 6, hd = cs / 3, part = cs - hd * 3;
      if (part == 2) { float o0, o1; rope_pair(p, row, col & 63, v0, v1, o0, o1); v0 = o0; v1 = o1; }
    };
    auto estore = [&](int row, int col0, int c, u32x4 d) {
      const int cs = col0 >> 6, hd = cs / 3, part = cs - hd * 3;
      const int b = row >> 12, s = row & 4095;
      st16(p.Qm + ((size_t)(b * 8 + hd) * 4096 + s) * 192 + part * 64 + 8 * c, d);
    };
    gemm_run<false>(wv, af, p.wt_mla_qb[j], 256, T, 6, vblock(), (int)gridDim.x, 128 * 6, emath, estore, NoPre(), smem);
  }
  {
    APlain af{p.kva, 128};
    auto emath = [&](int row, int col, float& v0, float& v1) {
      const float rs = rsqrtf(p.ssq_kv[row] * (1.f / 128.f) + 1e-6f);
      v0 *= rs; v1 *= rs;
    };
    auto estore = [&](int row, int col0, int c, u32x4 d) {
      const int cs = col0 >> 6, hd = cs >> 2, part = cs & 3;
      const int b = row >> 12, s = row & 4095;
      const size_t tok = (size_t)(b * 8 + hd) * 4096 + s;
      if (part < 2) st16(p.Km + tok * 192 + part * 64 + 8 * c, d);
      else st16(p.Vm + tok * 128 + (part - 2) * 64 + 8 * c, d);
    };
    gemm_run<false>(wv, af, p.wt_mla_kvb[j], 128, T, 8, vblock(), (int)gridDim.x, 128 * 8, emath, estore, NoPre(), smem);
  }
}

DI void item_map(int item, int ncombo, int nlevels, int& qt, int& combo) {
  const int g = gridDim.x;
  const int round = item / g, within = item - round * g;
  const int lpr = g / ncombo;
  const int li = within / ncombo;
  combo = within - li * ncombo;
  const int lvl = round * lpr + ((round & 1) ? (lpr - 1 - li) : li);
  qt = nlevels - 1 - lvl;
}

DI void phase_mla_attn(const int wv, const Params& p, char* smem) {
  const int t = tid(), lane = t & 63, wave = __builtin_amdgcn_readfirstlane(t >> 6), r = lane & 31, h = lane >> 5;
  for (int item = blockIdx.x; item < 1024; item += gridDim.x) {
    int qt, bh; item_map(item, 64, 16, qt, bh);
    const int q0 = qt * 256, qw = q0 + 32 * wave;
    const bf16* Qb = p.Qm + (size_t)bh * 4096 * 192;
    const bf16* Kb = p.Km + (size_t)bh * 4096 * 192;
    const bf16* Vb = p.Vm + (size_t)bh * 4096 * 128;
    bf16x8 qf[12];
#pragma unroll
    for (int ks = 0; ks < 12; ++ks) qf[ks] = *(const bf16x8*)(Qb + (size_t)(qw + r) * 192 + ks * 16 + h * 8);
    f32x16 ot[4]; float m, l;
    attn_core<192, 128, M_CAUSAL, 64>(wv, qf, Kb, 192, Vb, 128, q0, 256, qw, 0, 0ull, ot, m, l, smem);
    const float inv = 1.f / l;
    const int b = bh >> 3, hd = bh & 7;
    attn_store<128>(wv, ot, inv, p.sg, p.h, (size_t)b * 4096 + qw, hd * 128, smem);
  }
}

DI void phase_outproj(const int wv, const Params& p, int layer, const bf16* Wt, const float* xin, char* smem) {
  APlain af{p.h, 1024};
  auto emath = [&](int row, int col, float& v0, float& v1) {
    const float* gm = p.mod + ((size_t)layer * 8 + (row >> 12)) * 3072 + 2048;
    v0 *= gm[col]; v1 *= gm[col + 32];
  };
  auto estore = [&](int row, int col0, int c, u32x4 d) {
    const size_t o = (size_t)row * 1024 + col0 + 4 * c;
    const f32x4 xv = *(const f32x4*)(xin + o);
    const f32x4 yv = __builtin_bit_cast(f32x4, d);
    *(f32x4*)(p.out + o) = xv + yv;
  };
  gemm_phase<true>(wv, af, Wt, 1024, T, 1024, emath, estore, smem, 0);
}

DI void phase_swa_inproj(const int wv, const Params& p, char* smem) {
  APlain af{p.h, 1024};
  const float qscale = 0.125f * LOG2E;
  auto emath = [&](int row, int col, float& v0, float& v1) {
    const int cs = col >> 6;
    if (cs < 18) { float o0, o1; rope_pair(p, row, col & 63, v0, v1, o0, o1); const float sc = cs < 16 ? qscale : 1.f; v0 = o0 * sc; v1 = o1 * sc; }
    else if (cs >= 20) { v0 = silu_f(v0); v1 = silu_f(v1); }
  };
  auto estore = [&](int row, int col0, int c, u32x4 d) {
    const int cs = col0 >> 6;
    if (cs < 16) st16(p.Qs + (size_t)row * 1024 + col0 + 8 * c, d);
    else if (cs < 18) st16(p.Ks + (size_t)row * 128 + (col0 - 1024) + 8 * c, d);
    else if (cs < 20) st16(p.Vs + (size_t)row * 128 + (col0 - 1152) + 8 * c, d);
    else st16(p.sg + (size_t)row * 1024 + (col0 - 1280) + 8 * c, d);
  };
  gemm_phase<false>(wv, af, p.wt_swa_in, 1024, T, 2304, emath, estore, smem, 0);
}

DI void phase_swa_attn(const int wv, const Params& p, char* smem) {
  const int t = tid(), lane = t & 63, wave = __builtin_amdgcn_readfirstlane(t >> 6), r = lane & 31, h = lane >> 5;
  for (int item = vblock(); item < 2048; item += gridDim.x) {
    const int qt = item & 127, kvh = (item >> 7) & 1, b = item >> 8;
    const int hd = kvh * 8 + wave;
    const int q0 = qt * 32, qw = q0;
    const size_t tok = (size_t)b * 4096 + qw + r;
    bf16x8 qf[4];
#pragma unroll
    for (int ks = 0; ks < 4; ++ks) qf[ks] = *(const bf16x8*)(p.Qs + tok * 1024 + hd * 64 + ks * 16 + h * 8);
    f32x16 ot[2]; float m, l;
    attn_core<64, 64, M_WINDOW, 64>(wv, qf, p.Ks + (size_t)b * 4096 * 128 + kvh * 64, 128, p.Vs + (size_t)b * 4096 * 128 + kvh * 64, 128, q0, 32, qw, 128, 0ull, ot, m, l, smem);
    l += fexp2(p.swa_sinks[hd] * LOG2E - m);
    const float inv = 1.f / l;
    attn_store<64>(wv, ot, inv, p.sg, p.h, (size_t)b * 4096 + qw, hd * 64, smem);
  }
}

DI void phase_nsa_inproj(const int wv, const Params& p, char* smem) {
  APlain af{p.h, 1024};
  const float qscale = 0.125f * LOG2E;
  auto emath = [&](int row, int col, float& v0, float& v1) {
    const int cs = col >> 6;
    if (cs < 16) { float o0, o1; rope_pair(p, row, col & 63, v0, v1, o0, o1); v0 = o0 * qscale; v1 = o1 * qscale; }
    else if (cs < 40) {
      const int which = (cs - 16) >> 2;
      if (which == 2 || which == 4) { float o0, o1; rope_pair(p, row, col & 63, v0, v1, o0, o1); v0 = o0; v1 = o1; }
    } else if (cs < 56) { v0 = silu_f(v0); v1 = silu_f(v1); }
    else { v0 = 1.f / (1.f + __expf(-v0)); v1 = 1.f / (1.f + __expf(-v1)); }
  };
  auto estore = [&](int row, int col0, int c, u32x4 d) {
    const int cs = col0 >> 6;
    if (cs < 16) st16(p.Qs + (size_t)row * 1024 + col0 + 8 * c, d);
    else if (cs < 40) {
      const int which = (cs - 16) >> 2;
      bf16* dst = which == 0 ? p.kcmp : which == 1 ? p.vcmp : which == 2 ? p.kslc : which == 3 ? p.vslc : which == 4 ? p.kwin : p.vwin;
      st16(dst + (size_t)row * 256 + (col0 - 1024 - which * 256) + 8 * c, d);
    } else if (cs < 56) st16(p.sg + (size_t)row * 1024 + (col0 - 2560) + 8 * c, d);
    else if (cs == 56) { if (c < 6) st16(p.gb + (size_t)row * 48 + 8 * c, d); }
  };
  gemm_phase<false>(wv, af, p.wt_nsa_in, 1024, T, 3840, emath, estore, smem, 0);
}

DI void phase_nsa_cmp1(const int wv, const Params& p, char* smem) {
  for (int i = blockIdx.x * NT + tid(); i < 32 * 64; i += gridDim.x * NT) {
    int bk = i >> 6, d = i & 63;
    p.vc[((size_t)bk * 256 + 255) * 64 + d] = tobf(0.f);
    p.kc[((size_t)bk * 256 + 255) * 64 + d] = tobf(0.f);
  }
  float* pbs = (float*)(smem + GEMM_BUFE * 2 * 2);
  __syncthreads();
  if (tid() < 256) {
    const int tt = tid();
    float a = 0.f;
    for (int i = 0; i < 16; ++i) a += p.posbp[((tt >> 7) * 16 + i) * 128 + (tt & 127)];
    pbs[tt] = a;
  }
  __syncthreads();
  for (int which = 0; which < 2; ++which) {
    ACmp af{which ? p.vcmp : p.kcmp};
    bf16* hid = which ? p.hidv : p.hidk;
    const float* pb = pbs + which * 128;
    auto emath = [&](int row, int col, float& v0, float& v1) {
      if (col < 128) { v0 = silu_f(v0 + pb[col]); v1 = silu_f(v1 + pb[col + 32]); }
    };
    auto estore = [&](int row, int col0, int c, u32x4 d) {
      if (col0 < 128) st16(hid + (size_t)row * 128 + col0 + 8 * c, d);
    };
    gemm_phase<false>(wv, af, which ? p.wt_nsa_v1 : p.wt_nsa_k1, 2048, 8160, 256, emath, estore, smem, which * 32);
  }
}

DI void phase_nsa_cmp2(const int wv, const Params& p, char* smem) {
  for (int which = 0; which < 2; ++which) {
    APlain af{which ? p.hidv : p.hidk, 128};
    bf16* dst = which ? p.vc : p.kc;
    auto emath = [&](int, int, float&, float&) {};
    auto estore = [&](int row, int col0, int c, u32x4 d) {
      if (col0 == 0) {
        const int kvh = row & 3, bn = row >> 2, b = bn / 255, n = bn - b * 255;
        st16(dst + ((size_t)(b * 4 + kvh) * 256 + n) * 64 + 8 * c, d);
      }
    };
    gemm_phase<false>(wv, af, which ? p.wt_nsa_v2 : p.wt_nsa_k2, 128, 8160, 256, emath, estore, smem, which * 32);
  }
}

DI void nsa_select_item(const int wv, const Params& p, int item, float* impl, const bf16* skc) {
  const int lane = tid() & 63, r = lane & 31, h = lane >> 5;
  const int qt = item & 127, kvh = (item >> 7) & 3, b = item >> 9;
  const int qw = qt * 32, qblk = qw >> 6;
  uint64_t* dst = p.selmask + ((size_t)(b * 4 + kvh) * 4096 + qw);
  if (qblk < 16) { if (h == 0) dst[r] = (2ull << qblk) - 1ull; return; }
  const bf16* qrow = p.Qs + ((size_t)b * 4096 + qw + r) * 1024 + kvh * 256;
  const int qpos = qw + r;
  int nvis = (qpos - 31) >> 4; nvis = nvis < 254 ? nvis : 254;
  int nmaxw = qw >> 4; nmaxw = nmaxw < 254 ? nmaxw : 254;
  const int ntile = (nmaxw >> 5) + 1;
  for (int j = 0; j < 32; ++j) impl[j * 64 + lane] = 0.f;
  for (int g = 0; g < 4; ++g) {
    bf16x8 qf[4];
#pragma unroll
    for (int ks = 0; ks < 4; ++ks) qf[ks] = *(const bf16x8*)(qrow + g * 64 + ks * 16 + h * 8);
    float mg = -1e30f, lg = 0.f;
    for (int tt = 0; tt < ntile; ++tt) {
      f32x16 s;
#pragma unroll
      for (int i = 0; i < 16; ++i) s[i] = 0.f;
#pragma unroll
      for (int ks = 0; ks < 4; ++ks) s = mfma32(*(const bf16x8*)(skc + (tt * 32 + r) * 72 + ks * 16 + h * 8), qf[ks], s);
      float mx = mg;
#pragma unroll
      for (int i = 0; i < 16; ++i) { const int n = tt * 32 + crow(i, h); s[i] = (n <= nvis) ? s[i] : -INFINITY; mx = fmaxf(mx, s[i]); }
      float sum = 0.f;
#pragma unroll
      for (int i = 0; i < 16; ++i) sum += fexp2(s[i] - mx);
      lg = lg * fexp2(mg - mx) + sum; mg = mx;
    }
    {
      float mo = __shfl_xor(mg, 32), lo = __shfl_xor(lg, 32);
      float M = fmaxf(mg, mo);
      float L = lg * fexp2(mg - M) + lo * fexp2(mo - M);
      mg = M; lg = 1.f / L;
    }
    float pending = 0.f;
    for (int tt = 0; tt < ntile; ++tt) {
      f32x16 s;
#pragma unroll
      for (int i = 0; i < 16; ++i) s[i] = 0.f;
#pragma unroll
      for (int ks = 0; ks < 4; ++ks) s = mfma32(*(const bf16x8*)(skc + (tt * 32 + r) * 72 + ks * 16 + h * 8), qf[ks], s);
#pragma unroll
      for (int gq = 0; gq < 4; ++gq) {
        float pe[4];
#pragma unroll
        for (int e = 0; e < 4; ++e) { const int n = tt * 32 + 8 * gq + 4 * h + e; pe[e] = (n <= nvis) ? fexp2(s[4 * gq + e] - mg) * lg : 0.f; }
        const float cy = 0.5f * pe[3];
        const float rc = __shfl_xor(cy, 32);
        const float add = h ? rc : pending;
        pending = rc;
        impl[(4 * tt + gq) * 64 + lane] += pe[0] + pe[1] + pe[2] + cy + add;
      }
    }
  }
  float imp[32];
#pragma unroll
  for (int j = 0; j < 32; ++j) {
    const int bid = 2 * j + h;
    const bool excl = (bid > qblk) || (bid == 0) || (bid == qblk) || (bid == qblk - 1);
    imp[j] = excl ? -3.f : impl[j * 64 + lane];
  }
  uint32_t bits = 0;
  for (int it = 0; it < 13; ++it) {
    float best = imp[0]; int bj = 0;
#pragma unroll
    for (int j = 1; j < 32; ++j) { const bool gt = imp[j] > best; best = gt ? imp[j] : best; bj = gt ? j : bj; }
    const float pb = __shfl_xor(best, 32); const int pj = __shfl_xor(bj, 32);
    const int myid = 2 * bj + h, pid = 2 * pj + (1 - h);
    const bool win = (best > pb) || (best == pb && myid < pid);
#pragma unroll
    for (int j = 0; j < 32; ++j) imp[j] = (win && j == bj) ? -3.f : imp[j];
    bits |= win ? (1u << bj) : 0u;
  }
  uint64_t xm = bits;
  xm = (xm | (xm << 16)) & 0x0000FFFF0000FFFFull;
  xm = (xm | (xm << 8)) & 0x00FF00FF00FF00FFull;
  xm = (xm | (xm << 4)) & 0x0F0F0F0F0F0F0F0Full;
  xm = (xm | (xm << 2)) & 0x3333333333333333ull;
  xm = (xm | (xm << 1)) & 0x5555555555555555ull;
  xm <<= h;
  uint32_t lo = (uint32_t)xm, hi = (uint32_t)(xm >> 32);
  uint32_t plo = __shfl_xor(lo, 32), phi = __shfl_xor(hi, 32);
  uint64_t full = xm | ((uint64_t)phi << 32) | plo;
  full |= 1ull | (1ull << qblk) | (1ull << (qblk - 1));
  if (h == 0) dst[r] = full;
}

DI void phase_nsa_select(const int wv, const Params& p, char* smem) {
  const int t = tid(), wave = __builtin_amdgcn_readfirstlane(t >> 6);
  float* impl = (float*)smem + wave * 2048;
  bf16* skc = (bf16*)(smem + NW * 8192);
  for (int bi = blockIdx.x; bi < 4096 / NW; bi += gridDim.x) {
    const int item0 = bi * NW;
    const int kvh = (item0 >> 7) & 3, b = item0 >> 9;
    const bf16* kcg = p.kc + (size_t)(b * 4 + kvh) * 256 * 64;
    __syncthreads();
    for (int c = t; c < 256 * 8; c += NT) { const int row = c >> 3, ch = c & 7; *(u32x4*)(skc + row * 72 + ch * 8) = *(const u32x4*)(kcg + row * 64 + ch * 8); }
    __syncthreads();
    nsa_select_item(wv, p, item0 + wave, impl, skc);
  }
}

DI void phase_nsa_attn(const int wv, const Params& p, char* smem) {
  const int t = tid(), lane = t & 63, wave = __builtin_amdgcn_readfirstlane(t >> 6), r = lane & 31, h = lane >> 5;
  for (int item = blockIdx.x; item < 2048; item += gridDim.x) {
    int qt, bk; item_map(item, 32, 64, qt, bk);
    const int b = bk >> 2, kvh = bk & 3, hd = kvh * 4 + (wave >> 1);
    const int q0 = qt * 64, qw = q0 + 32 * (wave & 1);
    const size_t tok = (size_t)b * 4096 + qw + r;
    bf16x8 qf[4];
#pragma unroll
    for (int ks = 0; ks < 4; ++ks) qf[ks] = *(const bf16x8*)(p.Qs + tok * 1024 + hd * 64 + ks * 16 + h * 8);
    const float g0 = (float)p.gb[tok * 48 + hd * 3 + 0], g1 = (float)p.gb[tok * 48 + hd * 3 + 1], g2 = (float)p.gb[tok * 48 + hd * 3 + 2];
    const uint64_t selm = p.selmask[(size_t)(b * 4 + kvh) * 4096 + qw + r];
    f32x16 oacc[2], ot[2]; float m, l;
    attn_core<64, 64, M_CMP, 64>(wv, qf, p.kc + (size_t)(b * 4 + kvh) * 256 * 64, 64, p.vc + (size_t)(b * 4 + kvh) * 256 * 64, 64, q0, 64, qw, 0, 0ull, ot, m, l, smem);
    {
      const float w = (l > 0.f) ? g0 / l : 0.f;
#pragma unroll
      for (int d = 0; d < 2; ++d)
#pragma unroll
        for (int i = 0; i < 16; ++i) oacc[d][i] = ot[d][i] * w;
    }
    attn_core<64, 64, M_SEL, 64>(wv, qf, p.kslc + (size_t)b * 4096 * 256 + kvh * 64, 256, p.vslc + (size_t)b * 4096 * 256 + kvh * 64, 256, q0, 64, qw, 0, selm, ot, m, l, smem);
    {
      const float w = g1 / l;
#pragma unroll
      for (int d = 0; d < 2; ++d)
#pragma unroll
        for (int i = 0; i < 16; ++i) oacc[d][i] += ot[d][i] * w;
    }
    attn_core<64, 64, M_WINDOW, 64>(wv, qf, p.kwin + (size_t)b * 4096 * 256 + kvh * 64, 256, p.vwin + (size_t)b * 4096 * 256 + kvh * 64, 256, q0, 64, qw, 512, 0ull, ot, m, l, smem);
    {
      const float w = g2 / l;
#pragma unroll
      for (int d = 0; d < 2; ++d)
#pragma unroll
        for (int i = 0; i < 16; ++i) oacc[d][i] += ot[d][i] * w;
    }
    attn_store<64>(wv, oacc, 1.f, p.sg, p.h, (size_t)b * 4096 + qw, hd * 64, smem);
  }
}

#define XB_TMO      128
#define XB_XCNT(j)  (256  + 64 * (j))
#define XB_XSUB(j)  (1280 + 64 * (j))
#define XB_XGEN(j)  (2304 + 64 * (j))
#define XB_TOP      3328
#define XB_TOPGEN   3392
#define XCD_BAR_WORDS 3456
#define XB_SPIN_CAP (1u << 22)
#define LAS __attribute__((address_space(3)))
DI unsigned xb_ld(unsigned* p)              { return __hip_atomic_load(p, __ATOMIC_RELAXED, __HIP_MEMORY_SCOPE_AGENT); }
DI unsigned xb_add(unsigned* p, unsigned v) { return __hip_atomic_fetch_add(p, v, __ATOMIC_RELAXED, __HIP_MEMORY_SCOPE_AGENT); }
DI unsigned xb_xcc_id() { return (unsigned)__builtin_amdgcn_s_getreg((3 << 11) | 20) & 0xFu; }
#define XB_SPIN(cond, bar) do { unsigned _sp = 0; while (cond) { __builtin_amdgcn_s_sleep(1); \
    if ((++_sp & 255u) == 0u) { if (xb_ld(&(bar)[XB_TMO])) break; if (_sp > XB_SPIN_CAP) { atomicAdd(&(bar)[XB_TMO], 1u); break; } } } } while (0)
struct XcdBarrier { unsigned* bar; unsigned x; volatile LAS unsigned* st; int w0; };
DI bool xb_leader(int w0) { return w0 && __builtin_amdgcn_mbcnt_hi(~0u, __builtin_amdgcn_mbcnt_lo(~0u, 0u)) == 0; }
DI XcdBarrier xcd_barrier_post(unsigned* bar, volatile LAS unsigned* st, int w0) {
  XcdBarrier b; b.bar = bar; b.x = xb_xcc_id(); b.st = st; b.w0 = w0;
  if (xb_leader(w0)) (void)xb_add(&bar[XB_XCNT(b.x)], 1u);
  return b;
}
DI void xcd_barrier_complete(unsigned* bar, unsigned x, unsigned& nloc, unsigned& nx) {
  const unsigned G = gridDim.x * gridDim.y * gridDim.z;
  unsigned sum, cnt, mine, sp = 0u;
  for (;;) {
    sum = 0u; cnt = 0u; mine = 0u;
#pragma unroll
    for (unsigned j = 0; j < 16; ++j) { const unsigned c = xb_ld(&bar[XB_XCNT(j)]); sum += c; cnt += (c > 0u) ? 1u : 0u; mine = (j == x) ? c : mine; }
    if (sum == G) break;
    __builtin_amdgcn_s_sleep(1);
    if ((++sp & 255u) == 0u) { if (xb_ld(&bar[XB_TMO])) break; if (sp > XB_SPIN_CAP) { atomicAdd(&bar[XB_TMO], 1u); break; } }
  }
  nloc = mine > 0u ? mine : 1u; nx = cnt > 0u ? cnt : 1u;
}
DI void xcd_barrier(const XcdBarrier& b) {
  asm volatile("s_waitcnt vmcnt(0)" ::: "memory");
  __syncthreads();
  if (xb_leader(b.w0)) {
    unsigned* bar = b.bar;
    __builtin_amdgcn_s_waitcnt(0);
    unsigned nloc = b.st[0], nx = b.st[1];
    if (nloc == 0u) { xcd_barrier_complete(bar, b.x, nloc, nx); b.st[0] = nloc; b.st[1] = nx; }
    const unsigned old = xb_add(&bar[XB_XSUB(b.x)], 1u);
    const unsigned gen = old / nloc;
    if (old + 1u == (gen + 1u) * nloc) {
      __builtin_amdgcn_fence(__ATOMIC_RELEASE, "agent");
      asm volatile("s_waitcnt vmcnt(0)" ::: "memory");
      const unsigned og = xb_add(&bar[XB_TOP], 1u);
      const unsigned tg = og / nx;
      if (og + 1u == (tg + 1u) * nx) xb_add(&bar[XB_TOPGEN], 1u);
      else XB_SPIN(xb_ld(&bar[XB_TOPGEN]) == tg, bar);
      __builtin_amdgcn_fence(__ATOMIC_ACQUIRE, "agent");
      xb_add(&bar[XB_XGEN(b.x)], 1u);
      asm volatile("s_waitcnt vmcnt(0)" ::: "memory");
    } else {
      XB_SPIN(xb_ld(&bar[XB_XGEN(b.x)]) == gen, bar);
      __builtin_amdgcn_fence(__ATOMIC_ACQUIRE, "agent");
      asm volatile("s_waitcnt vmcnt(0)" ::: "memory");
    }
  }
  __syncthreads();
}

constexpr int NPHASE = 23;
#ifndef ONLY_PH
#define ONLY_PH -1
#endif
#ifndef DUP_MASK
#define DUP_MASK 0u
#endif
#define PHASE(i, call)                                                        \
  if ((ONLY_PH < 0 || ONLY_PH == (i)) && ph_begin <= (i) && (i) < ph_end) {   \
    call;                                                                     \
    if ((DUP_MASK >> (i)) & 1u) { __syncthreads(); call; }                    \
    if ((i) + 1 < ph_end) xcd_barrier(xb);                                    \
  }

__global__ void __launch_bounds__(NT, 2) mega(Params p_arg, int ph_begin, int ph_end) {
  __shared__ __attribute__((aligned(16))) char smem[SMEM_BYTES];
  cg::grid_group grid = cg::this_grid();
  const Params& p = *(const Params*)__builtin_amdgcn_kernarg_segment_ptr();
  const int wv = __builtin_amdgcn_readfirstlane((int)threadIdx.x >> 6);
  __shared__ __attribute__((aligned(16))) unsigned xb_words[4];
  if (threadIdx.x == 0) { xb_words[0] = 0u; xb_words[1] = 0u; xb_words[2] = 0u; xb_words[3] = 0u; }
  __syncthreads();
  if (ph_begin < 0) grid.sync();
  XcdBarrier xb = xcd_barrier_post(p.bar, (volatile LAS unsigned*)xb_words, wv == 0);
  PHASE(0, phase_prep(wv, p, smem))
  PHASE(1, (phase_norm(wv, p, 0, p.x), phase_prep_b(wv, p, smem)))
  PHASE(2, phase_mla_inproj(wv, p, 0, smem))
  PHASE(3, phase_mla_qkvb(wv, p, 0, smem))
  PHASE(4, phase_mla_attn(wv, p, smem))
  PHASE(5, phase_outproj(wv, p, 0, p.wt_mla_out[0], p.x, smem))
  PHASE(6, phase_norm(wv, p, 1, p.out))
  PHASE(7, phase_swa_inproj(wv, p, smem))
  PHASE(8, phase_swa_attn(wv, p, smem))
  PHASE(9, phase_outproj(wv, p, 1, p.wt_swa_out, p.out, smem))
  PHASE(10, phase_norm(wv, p, 2, p.out))
  PHASE(11, phase_nsa_inproj(wv, p, smem))
  PHASE(12, phase_nsa_cmp1(wv, p, smem))
  PHASE(13, phase_nsa_cmp2(wv, p, smem))
  PHASE(14, phase_nsa_select(wv, p, smem))
  PHASE(15, phase_nsa_attn(wv, p, smem))
  PHASE(16, phase_outproj(wv, p, 2, p.wt_nsa_out, p.out, smem))
  PHASE(17, phase_norm(wv, p, 3, p.out))
  PHASE(18, phase_mla_inproj(wv, p, 1, smem))
  PHASE(19, phase_mla_qkvb(wv, p, 1, smem))
  PHASE(20, phase_mla_attn(wv, p, smem))
  PHASE(21, phase_outproj(wv, p, 3, p.wt_mla_out[1], p.out, smem))
  PHASE(22, phase_final(wv, p))
}

#ifndef N_LAUNCH_MODE
#define N_LAUNCH_MODE 0
#endif

extern "C" void kernel_launch(void* const* d_in, const int* in_sizes, int n_in,
                              void* d_out, int out_size, void* d_ws, size_t ws_size,
                              hipStream_t stream) {
  static int grid_blocks = 0;
  if (!grid_blocks) {
    int dev = 0, cus = 0, per_cu = 0;
    (void)hipGetDevice(&dev);
    (void)hipDeviceGetAttribute(&cus, hipDeviceAttributeMultiprocessorCount, dev);
    (void)hipOccupancyMaxActiveBlocksPerMultiprocessor(&per_cu, mega, NT, 0);
    if (per_cu > 1) per_cu = 1;
    if (per_cu < 1) per_cu = 1;
    grid_blocks = 256 * per_cu;
    if (cus < 256) grid_blocks = 256;
  }
  Params p{};
  p.x = (const float*)d_in[0]; p.c = (const float*)d_in[1]; p.pos = (const int*)d_in[2];
  p.norm_g = (const float*)d_in[3]; p.ada_w = (const float*)d_in[4]; p.ada_b = (const float*)d_in[5];
  p.mla_w_in = (const float*)d_in[6]; p.mla_qg = (const float*)d_in[7]; p.mla_kvg = (const float*)d_in[8];
  p.mla_wqb = (const float*)d_in[9]; p.mla_wkvb = (const float*)d_in[10]; p.mla_wout = (const float*)d_in[11];
  p.swa_w_in = (const float*)d_in[12]; p.swa_sinks = (const float*)d_in[13]; p.swa_wout = (const float*)d_in[14];
  p.nsa_w_in = (const float*)d_in[15]; p.nsa_pos = (const float*)d_in[16]; p.nsa_k1 = (const float*)d_in[17];
  p.nsa_k2 = (const float*)d_in[18]; p.nsa_v1 = (const float*)d_in[19]; p.nsa_v2 = (const float*)d_in[20];
  p.nsa_wout = (const float*)d_in[21]; p.final_g = (const float*)d_in[22];
  p.out = (float*)d_out;
  char* w = (char*)d_ws; size_t off = 0;
  auto alloc = [&](size_t bytes) { void* r = w + off; off += (bytes + 255) & ~(size_t)255; return r; };
  p.bar = (unsigned*)alloc(16384);
  p.ssq_q = (float*)alloc((size_t)T * 4);
  p.ssq_kv = (float*)alloc((size_t)T * 4);
  for (int j = 0; j < 2; ++j) {
    p.wt_mla_in[j] = (bf16*)alloc((size_t)1536 * 1024 * 2);
    p.wt_mla_qb[j] = (bf16*)alloc((size_t)1536 * 256 * 2);
    p.wt_mla_kvb[j] = (bf16*)alloc((size_t)2048 * 128 * 2);
    p.wt_mla_out[j] = (bf16*)alloc((size_t)1024 * 1024 * 2);
  }
  p.wt_swa_in = (bf16*)alloc((size_t)2304 * 1024 * 2);
  p.wt_swa_out = (bf16*)alloc((size_t)1024 * 1024 * 2);
  p.wt_nsa_in = (bf16*)alloc((size_t)3840 * 1024 * 2);
  p.wt_nsa_k1 = (bf16*)alloc((size_t)256 * 2048 * 2);
  p.wt_nsa_k2 = (bf16*)alloc((size_t)256 * 128 * 2);
  p.wt_nsa_v1 = (bf16*)alloc((size_t)256 * 2048 * 2);
  p.wt_nsa_v2 = (bf16*)alloc((size_t)256 * 128 * 2);
  p.wt_nsa_out = (bf16*)alloc((size_t)1024 * 1024 * 2);
  p.mod = (float*)alloc((size_t)4 * 8 * 3072 * 4);
  p.rope = (float2*)alloc((size_t)T * 32 * 8);
  p.posbp = (float*)alloc((size_t)2 * 16 * 128 * 4);
  p.h = (bf16*)alloc((size_t)T * 1024 * 2);
  p.sg = (bf16*)alloc((size_t)T * 1024 * 2);
  const size_t region = off;
  p.qa = (bf16*)alloc((size_t)T * 256 * 2);
  p.kva = (bf16*)alloc((size_t)T * 128 * 2);
  p.Qm = (bf16*)alloc((size_t)T * 8 * 192 * 2);
  p.Km = (bf16*)alloc((size_t)T * 8 * 192 * 2);
  p.Vm = (bf16*)alloc((size_t)T * 8 * 128 * 2);
  off = region;
  p.Qs = (bf16*)alloc((size_t)T * 1024 * 2);
  p.Ks = (bf16*)alloc((size_t)T * 128 * 2);
  p.Vs = (bf16*)alloc((size_t)T * 128 * 2);
  p.kcmp = (bf16*)alloc((size_t)T * 256 * 2);
  p.vcmp = (bf16*)alloc((size_t)T * 256 * 2);
  p.kslc = (bf16*)alloc((size_t)T * 256 * 2);
  p.vslc = (bf16*)alloc((size_t)T * 256 * 2);
  p.kwin = (bf16*)alloc((size_t)T * 256 * 2);
  p.vwin = (bf16*)alloc((size_t)T * 256 * 2);
  p.gb = (bf16*)alloc((size_t)T * 48 * 2);
  p.hidk = (bf16*)alloc((size_t)8192 * 128 * 2);
  p.hidv = (bf16*)alloc((size_t)8192 * 128 * 2);
  p.kc = (bf16*)alloc((size_t)32 * 256 * 64 * 2);
  p.vc = (bf16*)alloc((size_t)32 * 256 * 64 * 2);
  p.selmask = (uint64_t*)alloc((size_t)32 * 4096 * 8);

#if N_LAUNCH_MODE == 0
  (void)hipMemsetAsync(p.bar, 0, 16384, stream);
  int b0 = 0, b1 = NPHASE;
  void* args[] = {&p, &b0, &b1};
  hipError_t e = hipLaunchCooperativeKernel((void*)mega, dim3(grid_blocks), dim3(NT), args, 0, stream);
  if (e != hipSuccess) fprintf(stderr, "cooperative launch failed: %s (grid %d)\n", hipGetErrorString(e), grid_blocks);
#else
  for (int ph = 0; ph < NPHASE; ++ph) hipLaunchKernelGGL(mega, dim3(grid_blocks), dim3(NT), 0, stream, p, ph, ph + 1);
#endif
}
```

```cpp
#include <hip/hip_runtime.h>
#include <hip/hip_cooperative_groups.h>
#include <stdint.h>
#include <cstdio>
namespace cg = cooperative_groups;

#define DI __device__ __forceinline__
typedef __bf16 bf16;
typedef __bf16 bf16x8 __attribute__((ext_vector_type(8)));
typedef __bf16 bf16x4 __attribute__((ext_vector_type(4)));
typedef __bf16 bf16x2 __attribute__((ext_vector_type(2)));
typedef float f32x16 __attribute__((ext_vector_type(16)));
typedef float f32x4 __attribute__((ext_vector_type(4)));
typedef float f32x2 __attribute__((ext_vector_type(2)));
typedef short s16x4 __attribute__((ext_vector_type(4)));
typedef short s16x8 __attribute__((ext_vector_type(8)));
typedef unsigned u32x4 __attribute__((ext_vector_type(4)));

constexpr int T = 32768, S = 4096;
constexpr float LOG2E = 1.4426950408889634f;
constexpr int NT = 512, NW = 8;
constexpr int SMEM_BYTES = 2 * 2 * 256 * 72 * 2 + 1024;

struct Params {
  const float *x, *c; const int* pos; const float *norm_g, *ada_w, *ada_b;
  const float *mla_w_in, *mla_qg, *mla_kvg, *mla_wqb, *mla_wkvb, *mla_wout;
  const float *swa_w_in, *swa_sinks, *swa_wout;
  const float *nsa_w_in, *nsa_pos, *nsa_k1, *nsa_k2, *nsa_v1, *nsa_v2, *nsa_wout;
  const float *final_g;
  float* out;
  bf16 *wt_mla_in[2], *wt_mla_qb[2], *wt_mla_kvb[2], *wt_mla_out[2];
  bf16 *wt_swa_in, *wt_swa_out, *wt_nsa_in, *wt_nsa_k1, *wt_nsa_k2, *wt_nsa_v1, *wt_nsa_v2, *wt_nsa_out;
  float* mod;
  float2* rope;
  float* posbp;
  bf16 *h, *sg;
  bf16 *qa, *kva, *Qm, *Km, *Vm;
  bf16 *Qs, *Ks, *Vs;
  bf16 *kcmp, *vcmp, *kslc, *vslc, *kwin, *vwin, *gb, *hidk, *hidv, *kc, *vc;
  uint64_t* selmask;
  unsigned* bar;
  float *ssq_q, *ssq_kv;
};

DI f32x16 mfma32(bf16x8 a, bf16x8 b, f32x16 c) { return __builtin_amdgcn_mfma_f32_32x32x16_bf16(a, b, c, 0, 0, 0); }
DI int crow(int i, int h) { return (i & 3) + 8 * (i >> 2) + 4 * h; }
DI float fexp2(float x) { return __builtin_amdgcn_exp2f(x); }
DI float silu_f(float v) { return v * __builtin_amdgcn_rcpf(1.f + __expf(-v)); }
DI bf16 tobf(float v) { return (bf16)v; }
DI int tid_(const int wv) { int l = __builtin_amdgcn_mbcnt_hi(~0u, __builtin_amdgcn_mbcnt_lo(~0u, 0u)); asm volatile("" : "+v"(l)); return wv * 64 + l; }
#define tid() tid_(wv)
DI int vblock() {
  const int g = gridDim.x, b = blockIdx.x;
  return ((g & 7) == 0) ? (b & 7) * (g >> 3) + (b >> 3) : b;
}

constexpr int GEMM_BUFE = 2 * 256 * 72;
struct NoPre { DI void operator()(int) const {} };
template <bool F32OUT, class AF, class MATH, class STORE, class PRE>
DI void gemm_run(const int wv, AF af, const bf16* __restrict__ Bt, int K, int M, int ntn, int tl0, int tstride, int ntiles, MATH emath, STORE estore, PRE pre, char* smem) {
  bf16* sbase = (bf16*)smem;
  const int t = tid(), lane = t & 63, wave = __builtin_amdgcn_readfirstlane(t >> 6), r = lane & 31, h = lane >> 5;
  const int wm = wave >> 1, wn = wave & 1;
  const int lrow = t >> 3, lkc = (t & 7) * 8;
  const int nk = K >> 6;
  u32x4 ra[4], rb[4];
  auto issue = [&](int tl, int ks) {
    const int mt = tl / ntn, n_t = tl - mt * ntn;
#pragma unroll
    for (int i = 0; i < 4; ++i) {
      const int row = lrow + 64 * i;
      int gm = mt * 256 + row; gm = gm < M ? gm : M - 1;
      ra[i] = *(const u32x4*)(af(gm, ks * 64 + lkc));
      rb[i] = *(const u32x4*)(Bt + (size_t)(n_t * 256 + row) * K + ks * 64 + lkc);
    }
  };
  if (tl0 < ntiles) issue(tl0, 0);
  for (int tl = tl0; tl < ntiles; tl += tstride) {
    const int mt = tl / ntn, n_t = tl - mt * ntn;
    const int m0 = mt * 256, n0 = n_t * 256;
    pre(m0);
    f32x16 acc[2][4];
#pragma unroll
    for (int a = 0; a < 2; ++a)
#pragma unroll
      for (int b = 0; b < 4; ++b)
#pragma unroll
        for (int i = 0; i < 16; ++i) acc[a][b][i] = 0.f;
    for (int s = 0; s < nk; ++s) {
      bf16* sA = sbase + (s & 1) * GEMM_BUFE;
      bf16* sB = sA + 256 * 72;
      int lro = lrow * 72 + lkc; asm volatile("" : "+v"(lro));
#pragma unroll
      for (int i = 0; i < 4; ++i) {
        *(u32x4*)(sA + lro + 64 * 72 * i) = ra[i];
        *(u32x4*)(sB + lro + 64 * 72 * i) = rb[i];
      }
      if (s + 1 < nk) issue(tl, s + 1);
      else if (tl + tstride < ntiles) issue(tl + tstride, 0);
      __syncthreads();
#pragma unroll
      for (int ks = 0; ks < 4; ++ks) {
        bf16x8 a0 = *(const bf16x8*)(sA + (wm * 64 + r) * 72 + ks * 16 + h * 8);
        bf16x8 a1 = *(const bf16x8*)(sA + (wm * 64 + 32 + r) * 72 + ks * 16 + h * 8);
#pragma unroll
        for (int nt = 0; nt < 4; ++nt) {
          bf16x8 bq = *(const bf16x8*)(sB + (wn * 128 + nt * 32 + r) * 72 + ks * 16 + h * 8);
          acc[0][nt] = mfma32(a0, bq, acc[0][nt]);
          acc[1][nt] = mfma32(a1, bq, acc[1][nt]);
        }
        if (ks == 1) __builtin_amdgcn_sched_barrier(0);
      }
    }
    __syncthreads();
    {
      int el = lane; asm volatile("" : "+v"(el));
      const int er = el & 31, eh = el >> 5;
      char* ebase = (char*)(sbase + GEMM_BUFE) + wave * (F32OUT ? 32 * 68 * 4 : 32 * 72 * 2);
      char* ewr = ebase + (F32OUT ? (4 * eh * 68 + er) * 4 : (4 * eh * 72 + er) * 2);
      const char* erd = ebase + (F32OUT ? ((el >> 4) * 68 + (el & 15) * 4) * 4 : ((el >> 3) * 72 + (el & 7) * 8) * 2);
      const int rd_row = F32OUT ? (el >> 4) : (el >> 3), rd_c = F32OUT ? (el & 15) : (el & 7);
#pragma unroll
      for (int mt2 = 0; mt2 < 2; ++mt2)
#pragma unroll
        for (int np = 0; np < 2; ++np) {
          const int col0 = n0 + wn * 128 + np * 64;
          const int rowb = m0 + wm * 64 + mt2 * 32;
#pragma unroll
          for (int i = 0; i < 16; ++i) {
            const int rlc = (i & 3) + 8 * (i >> 2);
            int row = rowb + rlc + 4 * eh; row = row < M ? row : M - 1;
            float v0 = acc[mt2][2 * np][i], v1 = acc[mt2][2 * np + 1][i];
            emath(row, col0 + er, v0, v1);
            if (F32OUT) { float* e = (float*)ewr; e[rlc * 68] = v0; e[rlc * 68 + 32] = v1; }
            else { bf16* e = (bf16*)ewr; e[rlc * 72] = tobf(v0); e[rlc * 72 + 32] = tobf(v1); }
          }
          if (F32OUT) {
#pragma unroll
            for (int k = 0; k < 8; ++k) {
              u32x4 d = *(const u32x4*)((const float*)erd + 4 * k * 68);
              if (rowb + rd_row + 4 * k < M) estore(rowb + rd_row + 4 * k, col0, rd_c, d);
            }
          } else {
#pragma unroll
            for (int k = 0; k < 4; ++k) {
              u32x4 d = *(const u32x4*)((const bf16*)erd + 8 * k * 72);
              if (rowb + rd_row + 8 * k < M) estore(rowb + rd_row + 8 * k, col0, rd_c, d);
            }
          }
        }
    }
  }
}

struct APlain {
  const bf16* A; int lda;
  DI const bf16* operator()(int row, int k) const { return A + (size_t)row * lda + k; }
};
struct ACmp {
  const bf16* src;
  DI const bf16* operator()(int row, int k) const {
    int kvh = row & 3, bn = row >> 2, b = bn / 255, n = bn - b * 255;
    return src + ((size_t)(b * 4096 + 16 * n + (k >> 6)) * 256 + kvh * 64) + (k & 63);
  }
};

enum { M_CAUSAL = 0, M_WINDOW = 1, M_CMP = 2, M_SEL = 3 };

template <int DQK, int DV, int MODE, int KT>
DI void attn_core(const int wv, const bf16x8 (&qf)[DQK / 16], const bf16* __restrict__ Kp, int ldk, const bf16* __restrict__ Vp, int ldv,
                  int q0, int qspan, int qw, int W, uint64_t selm, f32x16 (&ot)[DV / 32], float& m_out, float& l_out, char* smem) {
  constexpr int KS = DQK + 8, VS = DV + 32;
  constexpr int KCH = DQK / 8, VCH = DV / 8;
  constexpr int NKL = (KT * KCH + NT - 1) / NT, NVL = (KT * VCH + NT - 1) / NT;
  constexpr bool KPART = (KT * KCH) % NT != 0, VPART = (KT * VCH) % NT != 0;
  constexpr int NS = KT / 32;
  constexpr bool KLIN = (KCH & (KCH - 1)) != 0;
  constexpr int STG = KT * KS + KT * VS;
  bf16* const sbase = (bf16*)smem;
  const int t = tid(), lane = t & 63, wave = __builtin_amdgcn_readfirstlane(t >> 6), r = lane & 31, h = lane >> 5;
  const int qpos = qw + r;
  int kt_begin = 0, kt_end;
  if (MODE == M_WINDOW) { int s0 = q0 - W + 1; kt_begin = (s0 > 0 ? s0 : 0) / KT; }
  if (MODE == M_CMP) { int nmax = (q0 + qspan - 32) >> 4; nmax = nmax < 254 ? nmax : 254; kt_end = nmax / KT + 1; }
  else kt_end = (q0 + qspan + KT - 1) / KT;

#pragma unroll
  for (int d = 0; d < DV / 32; ++d)
#pragma unroll
    for (int i = 0; i < 16; ++i) ot[d][i] = 0.f;
  float m = -1e30f, l = 0.f;

  u32x4 rk[NKL], rv[NVL];
  const int krow0 = KLIN ? 0 : t / KCH, kcol0 = KLIN ? 0 : (t % KCH) * 8;
  const bf16* kgl = KLIN ? (Kp + t * 8) : (Kp + (size_t)krow0 * ldk + kcol0);
  const int vrow0 = t / VCH, vcol0 = (t % VCH) * 8;
  const bf16* vgl = Vp + (size_t)vrow0 * ldv + vcol0;
  auto gloadK = [&](int kt) {
    const bf16* kb = kgl + (size_t)(kt * KT) * ldk;
#pragma unroll
    for (int i = 0; i < NKL; ++i) if (!KPART || t + NT * i < KT * KCH) rk[i] = *(const u32x4*)(kb + (KLIN ? (size_t)i * (NT * 8) : (size_t)i * (NT / KCH) * ldk));
  };
  auto gloadV = [&](int kt) {
    const bf16* vb = vgl + (size_t)(kt * KT) * ldv;
#pragma unroll
    for (int i = 0; i < NVL; ++i) if (!VPART || t + NT * i < KT * VCH) rv[i] = *(const u32x4*)(vb + (size_t)i * (NT / VCH) * ldv);
  };
  gloadK(kt_begin); gloadV(kt_begin);
  const int i16 = lane & 15;
  const int vtr_off = KT * KS + (4 * h + (i16 >> 2)) * VS + 16 * ((lane >> 4) & 1) + 4 * (i16 & 3);
  __syncthreads();

  int ka = kt_begin, kb;
  if (MODE == M_CAUSAL) kb = (qw + 31) / KT + 1;
  else if (MODE == M_WINDOW) { int lo = qw - W + 1; lo = lo > 0 ? lo / KT : 0; ka = lo > kt_begin ? lo : kt_begin; kb = (qw + 31) / KT + 1; }
  else if (MODE == M_CMP) kb = qw / (16 * KT) + 1;
  else kb = (qw >> 6) + 1;
  kb = kb < kt_end ? kb : kt_end;
  kb = kb > ka ? kb : ka;
  auto advance = [&](int kt) {
    bf16* const sK = sbase + ((kt - kt_begin) & 1) * STG;
    bf16* const sV = sK + KT * KS;
#pragma unroll
    for (int i = 0; i < NKL; ++i) {
      if (!KPART || t + NT * i < KT * KCH) {
        if (KLIN) { int c = t + NT * i; int row = c / KCH, kc = c - row * KCH; *(u32x4*)(sK + row * KS + kc * 8) = rk[i]; }
        else *(u32x4*)(sK + (krow0 + i * (NT / KCH)) * KS + kcol0) = rk[i];
      }
    }
#pragma unroll
    for (int i = 0; i < NVL; ++i) if (!VPART || t + NT * i < KT * VCH) *(u32x4*)(sV + (vrow0 + i * (NT / VCH)) * VS + vcol0) = rv[i];
    if (kt + 1 < kt_end) { gloadK(kt + 1); gloadV(kt + 1); }
    __syncthreads();
  };
  for (int kt = kt_begin; kt < ka; ++kt) advance(kt);
  for (int kt = ka; kt < kb; ++kt) {
    advance(kt);
    bf16* const sK = sbase + ((kt - kt_begin) & 1) * STG;
    const bf16* const vtr = sK + vtr_off;
    const int k0 = kt * KT;
    bool needmask;
    if (MODE == M_CAUSAL) needmask = k0 + KT - 1 > qw;
    else if (MODE == M_WINDOW) needmask = !((k0 + KT - 1 <= qw) && (k0 >= qw + 32 - W));
    else needmask = true;

    f32x16 st[NS];
#pragma unroll
    for (int a = 0; a < NS; ++a)
#pragma unroll
      for (int i = 0; i < 16; ++i) st[a][i] = 0.f;
#pragma unroll
    for (int ks = 0; ks < DQK / 16; ++ks) {
#pragma unroll
      for (int a = 0; a < NS; ++a) {
        bf16x8 af_ = *(const bf16x8*)(sK + (32 * a + r) * KS + ks * 16 + h * 8);
        st[a] = mfma32(af_, qf[ks], st[a]);
      }
    }
    const bool selbit = (MODE == M_SEL) ? ((selm >> (k0 >> 6)) & 1ull) != 0 : true;
    const bool emask = (MODE == M_SEL) ? (k0 + KT - 1 > qw) : needmask;
    if (emask) {
#pragma unroll
      for (int a = 0; a < NS; ++a)
#pragma unroll
        for (int i = 0; i < 16; ++i) {
          const int kpos = k0 + 32 * a + crow(i, h);
          bool ok;
          if (MODE == M_CAUSAL) ok = kpos <= qpos;
          else if (MODE == M_WINDOW) ok = (kpos <= qpos) && (kpos + W > qpos);
          else if (MODE == M_CMP) ok = (16 * kpos + 31 <= qpos) && (kpos <= 254);
          else ok = kpos <= qpos;
          st[a][i] = ok ? st[a][i] : -INFINITY;
        }
    }
    float tmax = -INFINITY;
#pragma unroll
    for (int a = 0; a < NS; ++a)
#pragma unroll
      for (int i = 0; i < 16; ++i) tmax = fmaxf(tmax, st[a][i]);
    tmax = fmaxf(tmax, __shfl_xor(tmax, 32));
    if (MODE == M_SEL) tmax = selbit ? tmax : -INFINITY;
    if (__any(tmax > m + 8.f)) {
      const float mnew = fmaxf(m, tmax);
      const float alpha = fexp2(m - mnew);
      m = mnew;
      l *= alpha;
#pragma unroll
      for (int d = 0; d < DV / 32; ++d)
#pragma unroll
        for (int i = 0; i < 16; ++i) ot[d][i] *= alpha;
    }
    const float ms = (MODE == M_SEL && !selbit) ? INFINITY : m;
    float ls = 0.f;
#pragma unroll
    for (int a = 0; a < NS; ++a)
#pragma unroll
      for (int i = 0; i < 16; ++i) { float pv = fexp2(st[a][i] - ms); st[a][i] = pv; ls += pv; }
    l += ls;
#pragma unroll
    for (int kk = 0; kk < 2 * NS; ++kk) {
      bf16x8 pf;
#pragma unroll
      for (int j = 0; j < 8; ++j) pf[j] = (bf16)st[kk >> 1][8 * (kk & 1) + j];
#pragma unroll
      for (int d = 0; d < DV / 32; ++d) {
        s16x4 lo = __builtin_amdgcn_ds_read_tr16_b64_v4i16((__attribute__((address_space(3))) s16x4*)(vtr + (16 * kk) * VS + 32 * d));
        s16x4 hi = __builtin_amdgcn_ds_read_tr16_b64_v4i16((__attribute__((address_space(3))) s16x4*)(vtr + (16 * kk + 8) * VS + 32 * d));
        s16x8 v8 = __builtin_shufflevector(lo, hi, 0, 1, 2, 3, 4, 5, 6, 7);
        ot[d] = mfma32(__builtin_bit_cast(bf16x8, v8), pf, ot[d]);
      }
    }
  }
  for (int kt = kb; kt < kt_end; ++kt) advance(kt);
  l_out = l + __shfl_xor(l, 32);
  m_out = m;
}

constexpr int ATT_EPI_OFF = 96 * 1024;
template <int DV>
DI void attn_store(const int wv, const f32x16 (&ot)[DV / 32], float scale, const bf16* __restrict__ sg, bf16* __restrict__ out,
                   size_t tok0, int col0, char* smem) {
  const int t = tid(), lane = t & 63, wave = __builtin_amdgcn_readfirstlane(t >> 6), r = lane & 31, h = lane >> 5;
  bf16* e = (bf16*)(smem + ATT_EPI_OFF + wave * (32 * 72 * 2));
#pragma unroll
  for (int hf = 0; hf < DV / 64; ++hf) {
#pragma unroll
    for (int dd = 0; dd < 2; ++dd)
#pragma unroll
      for (int g = 0; g < 4; ++g) {
        bf16x4 o;
#pragma unroll
        for (int k = 0; k < 4; ++k) o[k] = tobf(ot[2 * hf + dd][4 * g + k] * scale);
        *(bf16x4*)(e + r * 72 + 32 * dd + 8 * g + 4 * h) = o;
      }
#pragma unroll
    for (int k = 0; k < 4; ++k) {
      const int rl = (lane >> 3) + 8 * k, c = lane & 7;
      const bf16x8 ov = *(const bf16x8*)(e + rl * 72 + c * 8);
      const size_t off = (tok0 + rl) * 1024 + col0 + 64 * hf + c * 8;
      const bf16x8 gv = *(const bf16x8*)(sg + off);
      bf16x8 res;
#pragma unroll
      for (int q = 0; q < 8; ++q) res[q] = tobf((float)ov[q] * (float)gv[q]);
      *(bf16x8*)(out + off) = res;
    }
  }
}

DI void prep_transpose(const int wv, const float* __restrict__ W, int K, int N, int Npad, bf16* __restrict__ dst, const float* __restrict__ kscale, int perm, char* smem) {
  float* tile = (float*)smem;
  const int t = tid();
  const int ntk = K / 64, ntn = Npad / 64;
  for (int tl = vblock(); tl < ntk * ntn; tl += gridDim.x) {
    const int tn = tl / ntk, tk = tl - tn * ntk;
    __syncthreads();
#pragma unroll
    for (int i = 0; i < 64 / NW; ++i) {
      int kk = i * NW + (t >> 6), nn = t & 63;
      int j = tn * 64 + nn;
      int src = j;
      if (perm) { src = (j < 2560) ? j : (j < 3584 ? j + 48 : j - 1024); }
      float v = 0.f;
      if (j < N) { v = W[(size_t)(tk * 64 + kk) * N + src]; if (kscale) v *= kscale[tk * 64 + kk]; }
      tile[kk * 65 + nn] = v;
    }
    __syncthreads();
#pragma unroll
    for (int i = 0; i < 64 / NW; ++i) {
      int nn = i * NW + (t >> 6), kk = t & 63;
      dst[(size_t)(tn * 64 + nn) * K + tk * 64 + kk] = tobf(tile[kk * 65 + nn]);
    }
  }
}

DI void phase_prep(const int wv, const Params& p, char* smem) {
  const int t = tid();
  const float invf = (float)pow(10000.0, -(double)(t & 31) / 32.0);
  for (int i = blockIdx.x * NT + t; i < T * 32; i += gridDim.x * NT) {
    int tok = i >> 5;
    float ang = (float)p.pos[tok] * invf;
    float sn, cs; sincosf(ang, &sn, &cs);
    p.rope[i] = make_float2(cs, sn);
  }
  {
    float* cond = (float*)smem;
    float* red = cond + 8192;
    for (int task = gridDim.x - 1 - blockIdx.x; task < 192; task += gridDim.x) {
      __syncthreads();
      for (int i = t; i < 8192; i += NT) cond[i] = silu_f(p.c[i]);
      __syncthreads();
      const int layer = task / 48, cg_ = task % 48, lane = t & 63, wave = t >> 6;
      const int col = cg_ * 64 + lane;
      const float* w = p.ada_w + (size_t)layer * 1024 * 3072 + col;
      float acc[8];
#pragma unroll
      for (int b = 0; b < 8; ++b) acc[b] = 0.f;
      for (int k = wave * (1024 / NW); k < (wave + 1) * (1024 / NW); k += 16) {
        float wq[16];
#pragma unroll
        for (int u = 0; u < 16; ++u) wq[u] = w[(size_t)(k + u) * 3072];
#pragma unroll
        for (int u = 0; u < 16; ++u)
#pragma unroll
          for (int b = 0; b < 8; ++b) acc[b] += cond[b * 1024 + k + u] * wq[u];
      }
#pragma unroll
      for (int b = 0; b < 8; ++b) red[(wave * 8 + b) * 64 + lane] = acc[b];
      __syncthreads();
      for (int i = t; i < 512; i += NT) {
        int b = i >> 6, ln = i & 63;
        float s = 0.f;
#pragma unroll
        for (int w = 0; w < NW; ++w) s += red[(w * 8 + b) * 64 + ln];
        int cc = cg_ * 64 + ln;
        p.mod[((size_t)layer * 8 + b) * 3072 + cc] = s + p.ada_b[layer * 3072 + cc];
      }
    }
  }
}

DI void phase_prep_b(const int wv, const Params& p, char* smem) {
  const int t = tid();
  {
    for (int task = blockIdx.x; task < 32; task += gridDim.x) {
      const int which = task >> 4, kcid = task & 15;
      const float* w1 = which ? p.nsa_v1 : p.nsa_k1;
      __syncthreads();
      const int col = t & 127, part = t >> 7;
      constexpr int RPG = 128 / (NT / 128);
      float s = 0.f;
      for (int k = kcid * 128 + part * RPG; k < kcid * 128 + (part + 1) * RPG; ++k) s += p.nsa_pos[k] * w1[(size_t)k * 128 + col];
      float* red2 = (float*)smem;
      red2[t] = s;
      __syncthreads();
      if (t < 128) { float a = 0.f; for (int q = 0; q < NT / 128; ++q) a += red2[t + 128 * q]; p.posbp[(which * 16 + kcid) * 128 + t] = a; }
    }
  }
  for (int j = 0; j < 2; ++j) {
    prep_transpose(wv, p.mla_w_in + (size_t)j * 1024 * 1472, 1024, 1472, 1536, p.wt_mla_in[j], nullptr, 0, smem);
    prep_transpose(wv, p.mla_wqb + (size_t)j * 256 * 1536, 256, 1536, 1536, p.wt_mla_qb[j], p.mla_qg + j * 256, 0, smem);
    prep_transpose(wv, p.mla_wkvb + (size_t)j * 128 * 2048, 128, 2048, 2048, p.wt_mla_kvb[j], p.mla_kvg + j * 128, 0, smem);
    prep_transpose(wv, p.mla_wout + (size_t)j * 1024 * 1024, 1024, 1024, 1024, p.wt_mla_out[j], nullptr, 0, smem);
  }
  prep_transpose(wv, p.swa_w_in, 1024, 2304, 2304, p.wt_swa_in, nullptr, 0, smem);
  prep_transpose(wv, p.swa_wout, 1024, 1024, 1024, p.wt_swa_out, nullptr, 0, smem);
  prep_transpose(wv, p.nsa_w_in, 1024, 3632, 3840, p.wt_nsa_in, nullptr, 1, smem);
  prep_transpose(wv, p.nsa_k1, 2048, 128, 256, p.wt_nsa_k1, nullptr, 0, smem);
  prep_transpose(wv, p.nsa_k2, 128, 64, 256, p.wt_nsa_k2, nullptr, 0, smem);
  prep_transpose(wv, p.nsa_v1, 2048, 128, 256, p.wt_nsa_v1, nullptr, 0, smem);
  prep_transpose(wv, p.nsa_v2, 128, 64, 256, p.wt_nsa_v2, nullptr, 0, smem);
  prep_transpose(wv, p.nsa_wout, 1024, 1024, 1024, p.wt_nsa_out, nullptr, 0, smem);
}

DI void phase_norm(const int wv, const Params& p, int layer, const float* __restrict__ xin) {
  const int lane = tid() & 63, wave = tid() >> 6;
  const float* g = p.norm_g + layer * 1024;
  for (int row = blockIdx.x * NW + wave; row < T; row += gridDim.x * NW) {
    const int b = row >> 12;
    const float* md = p.mod + ((size_t)layer * 8 + b) * 3072;
    const float4* xr = (const float4*)(xin + (size_t)row * 1024);
    float4 v[4]; float s = 0.f;
#pragma unroll
    for (int i = 0; i < 4; ++i) { v[i] = xr[lane + 64 * i]; s += v[i].x * v[i].x + v[i].y * v[i].y + v[i].z * v[i].z + v[i].w * v[i].w; }
#pragma unroll
    for (int o = 32; o > 0; o >>= 1) s += __shfl_xor(s, o);
    const float rs = rsqrtf(s * (1.f / 1024.f) + 1e-6f);
    if (lane == 0) { p.ssq_q[row] = 0.f; p.ssq_kv[row] = 0.f; }
#pragma unroll
    for (int i = 0; i < 4; ++i) {
      const int c = (lane + 64 * i) * 4;
      float4 gg = *(const float4*)(g + c), sh = *(const float4*)(md + c), sc = *(const float4*)(md + 1024 + c);
      bf16x4 o;
      o[0] = tobf(v[i].x * rs * gg.x * (1.f + sc.x) + sh.x);
      o[1] = tobf(v[i].y * rs * gg.y * (1.f + sc.y) + sh.y);
      o[2] = tobf(v[i].z * rs * gg.z * (1.f + sc.z) + sh.z);
      o[3] = tobf(v[i].w * rs * gg.w * (1.f + sc.w) + sh.w);
      *(bf16x4*)(p.h + (size_t)row * 1024 + c) = o;
    }
  }
}

DI void phase_final(const int wv, const Params& p) {
  const int lane = tid() & 63, wave = tid() >> 6;
  for (int row = blockIdx.x * NW + wave; row < T; row += gridDim.x * NW) {
    float4* xr = (float4*)(p.out + (size_t)row * 1024);
    float4 v[4]; float s = 0.f;
#pragma unroll
    for (int i = 0; i < 4; ++i) { v[i] = xr[lane + 64 * i]; s += v[i].x * v[i].x + v[i].y * v[i].y + v[i].z * v[i].z + v[i].w * v[i].w; }
#pragma unroll
    for (int o = 32; o > 0; o >>= 1) s += __shfl_xor(s, o);
    const float rs = rsqrtf(s * (1.f / 1024.f) + 1e-6f);
#pragma unroll
    for (int i = 0; i < 4; ++i) {
      float4 gg = *(const float4*)(p.final_g + (lane + 64 * i) * 4);
      xr[lane + 64 * i] = make_float4(v[i].x * rs * gg.x, v[i].y * rs * gg.y, v[i].z * rs * gg.z, v[i].w * rs * gg.w);
    }
  }
}

DI void rope_pair(const Params& p, int row, int f, float v0, float v1, float& o0, float& o1) {
  float2 cs = p.rope[(size_t)row * 32 + f];
  o0 = v0 * cs.x - v1 * cs.y;
  o1 = v1 * cs.x + v0 * cs.y;
}

template <bool F32OUT, class AF, class MATH, class STORE>
DI void gemm_phase(const int wv, AF af, const bf16* Bt, int K, int M, int Npad, MATH emath, STORE estore, char* smem, int tile_off) {
  const int ntn = Npad / 256, ntm = (M + 255) / 256, nt = ntn * ntm;
  int first = vblock() - (tile_off % (int)gridDim.x);
  if (first < 0) first += gridDim.x;
  gemm_run<F32OUT>(wv, af, Bt, K, M, ntn, first, (int)gridDim.x, nt, emath, estore, NoPre(), smem);
}
DI void st16(bf16* dst, u32x4 d) { *(u32x4*)dst = d; }

DI void phase_mla_inproj(const int wv, const Params& p, int j, char* smem) {
  APlain af{p.h, 1024};
  auto emath = [&](int row, int col, float& v0, float& v1) {
    const int cs = col >> 6;
    if (cs == 6) { float o0, o1; rope_pair(p, row, col - 384, v0, v1, o0, o1); v0 = o0; v1 = o1; }
    else if (cs >= 7) { v0 = silu_f(v0); v1 = silu_f(v1); }
  };
  auto estore = [&](int row, int col0, int c, u32x4 d) {
    const int cs = col0 >> 6;
    if (cs < 6) {
      const bf16x8 dv = __builtin_bit_cast(bf16x8, d);
      float sq = 0.f;
#pragma unroll
      for (int e = 0; e < 8; ++e) { const float f = (float)dv[e]; sq += f * f; }
      sq += __shfl_xor(sq, 1); sq += __shfl_xor(sq, 2); sq += __shfl_xor(sq, 4);
      if (cs < 4) { st16(p.qa + (size_t)row * 256 + col0 + 8 * c, d); if (c == 0) atomicAdd(p.ssq_q + row, sq); }
      else { st16(p.kva + (size_t)row * 128 + (col0 - 256) + 8 * c, d); if (c == 0) atomicAdd(p.ssq_kv + row, sq); }
    }
    else if (cs == 6) {
      const int b = row >> 12, s = row & 4095;
      bf16* kr = p.Km + ((size_t)(b * 8) * 4096 + s) * 192 + 128 + 8 * c;
#pragma unroll 1
      for (int hd = 0; hd < 8; ++hd) { st16(kr, d); kr += (size_t)4096 * 192; }
    } else if (cs < 23) st16(p.sg + (size_t)row * 1024 + (col0 - 448) + 8 * c, d);
  };
  gemm_phase<false>(wv, af, p.wt_mla_in[j], 1024, T, 1536, emath, estore, smem, 0);
}

DI void phase_mla_qkvb(const int wv, const Params& p, int j, char* smem) {
  {
    const float qscale = 0.07216878364870322f * LOG2E;
    APlain af{p.qa, 256};
    auto emath = [&](int row, int col, float& v0, float& v1) {
      const float rs = rsqrtf(p.ssq_q[row] * (1.f / 256.f) + 1e-6f) * qscale;
      v0 *= rs; v1 *= rs;
      const int cs = col >> 6, hd = cs / 3, part = cs - hd * 3;
      if (part == 2) { float o0, o1; rope_pair(p, row, col & 63, v0, v1, o0, o1); v0 = o0; v1 = o1; }
    };
    auto estore = [&](int row, int col0, int c, u32x4 d) {
      const int cs = col0 >> 6, hd = cs / 3, part = cs - hd * 3;
      const int b = row >> 12, s = row & 4095;
      st16(p.Qm + ((size_t)(b * 8 + hd) * 4096 + s) * 192 + part * 64 + 8 * c, d);
    };
    gemm_run<false>(wv, af, p.wt_mla_qb[j], 256, T, 6, vblock(), (int)gridDim.x, 128 * 6, emath, estore, NoPre(), smem);
  }
  {
    APlain af{p.kva, 128};
    auto emath = [&](int row, int col, float& v0, float& v1) {
      const float rs = rsqrtf(p.ssq_kv[row] * (1.f / 128.f) + 1e-6f);
      v0 *= rs; v1 *= rs;
    };
    auto estore = [&](int row, int col0, int c, u32x4 d) {
      const int cs = col0 >> 6, hd = cs >> 2, part = cs & 3;
      const int b = row >> 12, s = row & 4095;
      const size_t tok = (size_t)(b * 8 + hd) * 4096 + s;
      if (part < 2) st16(p.Km + tok * 192 + part * 64 + 8 * c, d);
      else st16(p.Vm + tok * 128 + (part - 2) * 64 + 8 * c, d);
    };
    gemm_run<false>(wv, af, p.wt_mla_kvb[j], 128, T, 8, vblock(), (int)gridDim.x, 128 * 8, emath, estore, NoPre(), smem);
  }
}

DI void item_map(int item, int ncombo, int nlevels, int& qt, int& combo) {
  const int g = gridDim.x;
  const int round = item / g, within = item - round * g;
  const int lpr = g / ncombo;
  const int li = within / ncombo;
  combo = within - li * ncombo;
  const int lvl = round * lpr + ((round & 1) ? (lpr - 1 - li) : li);
  qt = nlevels - 1 - lvl;
}

DI void phase_mla_attn(const int wv, const Params& p, char* smem) {
  const int t = tid(), lane = t & 63, wave = __builtin_amdgcn_readfirstlane(t >> 6), r = lane & 31, h = lane >> 5;
  for (int item = blockIdx.x; item < 1024; item += gridDim.x) {
    int qt, bh; item_map(item, 64, 16, qt, bh);
    const int q0 = qt * 256, qw = q0 + 32 * wave;
    const bf16* Qb = p.Qm + (size_t)bh * 4096 * 192;
    const bf16* Kb = p.Km + (size_t)bh * 4096 * 192;
    const bf16* Vb = p.Vm + (size_t)bh * 4096 * 128;
    bf16x8 qf[12];
#pragma unroll
    for (int ks = 0; ks < 12; ++ks) qf[ks] = *(const bf16x8*)(Qb + (size_t)(qw + r) * 192 + ks * 16 + h * 8);
    f32x16 ot[4]; float m, l;
    attn_core<192, 128, M_CAUSAL, 64>(wv, qf, Kb, 192, Vb, 128, q0, 256, qw, 0, 0ull, ot, m, l, smem);
    const float inv = 1.f / l;
    const int b = bh >> 3, hd = bh & 7;
    attn_store<128>(wv, ot, inv, p.sg, p.h, (size_t)b * 4096 + qw, hd * 128, smem);
  }
}

DI void phase_outproj(const int wv, const Params& p, int layer, const bf16* Wt, const float* xin, char* smem) {
  APlain af{p.h, 1024};
  auto emath = [&](int row, int col, float& v0, float& v1) {
    const float* gm = p.mod + ((size_t)layer * 8 + (row >> 12)) * 3072 + 2048;
    v0 *= gm[col]; v1 *= gm[col + 32];
  };
  auto estore = [&](int row, int col0, int c, u32x4 d) {
    const size_t o = (size_t)row * 1024 + col0 + 4 * c;
    const f32x4 xv = *(const f32x4*)(xin + o);
    const f32x4 yv = __builtin_bit_cast(f32x4, d);
    *(f32x4*)(p.out + o) = xv + yv;
  };
  gemm_phase<true>(wv, af, Wt, 1024, T, 1024, emath, estore, smem, 0);
}

DI void phase_swa_inproj(const int wv, const Params& p, char* smem) {
  APlain af{p.h, 1024};
  const float qscale = 0.125f * LOG2E;
  auto emath = [&](int row, int col, float& v0, float& v1) {
    const int cs = col >> 6;
    if (cs < 18) { float o0, o1; rope_pair(p, row, col & 63, v0, v1, o0, o1); const float sc = cs < 16 ? qscale : 1.f; v0 = o0 * sc; v1 = o1 * sc; }
    else if (cs >= 20) { v0 = silu_f(v0); v1 = silu_f(v1); }
  };
  auto estore = [&](int row, int col0, int c, u32x4 d) {
    const int cs = col0 >> 6;
    if (cs < 16) st16(p.Qs + (size_t)row * 1024 + col0 + 8 * c, d);
    else if (cs < 18) st16(p.Ks + (size_t)row * 128 + (col0 - 1024) + 8 * c, d);
    else if (cs < 20) st16(p.Vs + (size_t)row * 128 + (col0 - 1152) + 8 * c, d);
    else st16(p.sg + (size_t)row * 1024 + (col0 - 1280) + 8 * c, d);
  };
  gemm_phase<false>(wv, af, p.wt_swa_in, 1024, T, 2304, emath, estore, smem, 0);
}

DI void phase_swa_attn(const int wv, const Params& p, char* smem) {
  const int t = tid(), lane = t & 63, wave = __builtin_amdgcn_readfirstlane(t >> 6), r = lane & 31, h = lane >> 5;
  for (int item = vblock(); item < 2048; item += gridDim.x) {
    const int qt = item & 127, kvh = (item >> 7) & 1, b = item >> 8;
    const int hd = kvh * 8 + wave;
    const int q0 = qt * 32, qw = q0;
    const size_t tok = (size_t)b * 4096 + qw + r;
    bf16x8 qf[4];
#pragma unroll
    for (int ks = 0; ks < 4; ++ks) qf[ks] = *(const bf16x8*)(p.Qs + tok * 1024 + hd * 64 + ks * 16 + h * 8);
    f32x16 ot[2]; float m, l;
    attn_core<64, 64, M_WINDOW, 64>(wv, qf, p.Ks + (size_t)b * 4096 * 128 + kvh * 64, 128, p.Vs + (size_t)b * 4096 * 128 + kvh * 64, 128, q0, 32, qw, 128, 0ull, ot, m, l, smem);
    l += fexp2(p.swa_sinks[hd] * LOG2E - m);
    const float inv = 1.f / l;
    attn_store<64>(wv, ot, inv, p.sg, p.h, (size_t)b * 4096 + qw, hd * 64, smem);
  }
}

DI void phase_nsa_inproj(const int wv, const Params& p, char* smem) {
  APlain af{p.h, 1024};
  const float qscale = 0.125f * LOG2E;
  auto emath = [&](int row, int col, float& v0, float& v1) {
    const int cs = col >> 6;
    if (cs < 16) { float o0, o1; rope_pair(p, row, col & 63, v0, v1, o0, o1); v0 = o0 * qscale; v1 = o1 * qscale; }
    else if (cs < 40) {
      const int which = (cs - 16) >> 2;
      if (which == 2 || which == 4) { float o0, o1; rope_pair(p, row, col & 63, v0, v1, o0, o1); v0 = o0; v1 = o1; }
    } else if (cs < 56) { v0 = silu_f(v0); v1 = silu_f(v1); }
    else { v0 = 1.f / (1.f + __expf(-v0)); v1 = 1.f / (1.f + __expf(-v1)); }
  };
  auto estore = [&](int row, int col0, int c, u32x4 d) {
    const int cs = col0 >> 6;
    if (cs < 16) st16(p.Qs + (size_t)row * 1024 + col0 + 8 * c, d);
    else if (cs < 40) {
      const int which = (cs - 16) >> 2;
      bf16* dst = which == 0 ? p.kcmp : which == 1 ? p.vcmp : which == 2 ? p.kslc : which == 3 ? p.vslc : which == 4 ? p.kwin : p.vwin;
      st16(dst + (size_t)row * 256 + (col0 - 1024 - which * 256) + 8 * c, d);
    } else if (cs < 56) st16(p.sg + (size_t)row * 1024 + (col0 - 2560) + 8 * c, d);
    else if (cs == 56) { if (c < 6) st16(p.gb + (size_t)row * 48 + 8 * c, d); }
  };
  gemm_phase<false>(wv, af, p.wt_nsa_in, 1024, T, 3840, emath, estore, smem, 0);
}

DI void phase_nsa_cmp1(const int wv, const Params& p, char* smem) {
  for (int i = blockIdx.x * NT + tid(); i < 32 * 64; i += gridDim.x * NT) {
    int bk = i >> 6, d = i & 63;
    p.vc[((size_t)bk * 256 + 255) * 64 + d] = tobf(0.f);
    p.kc[((size_t)bk * 256 + 255) * 64 + d] = tobf(0.f);
  }
  float* pbs = (float*)(smem + GEMM_BUFE * 2 * 2);
  __syncthreads();
  if (tid() < 256) {
    const int tt = tid();
    float a = 0.f;
    for (int i = 0; i < 16; ++i) a += p.posbp[((tt >> 7) * 16 + i) * 128 + (tt & 127)];
    pbs[tt] = a;
  }
  __syncthreads();
  for (int which = 0; which < 2; ++which) {
    ACmp af{which ? p.vcmp : p.kcmp};
    bf16* hid = which ? p.hidv : p.hidk;
    const float* pb = pbs + which * 128;
    auto emath = [&](int row, int col, float& v0, float& v1) {
      if (col < 128) { v0 = silu_f(v0 + pb[col]); v1 = silu_f(v1 + pb[col + 32]); }
    };
    auto estore = [&](int row, int col0, int c, u32x4 d) {
      if (col0 < 128) st16(hid + (size_t)row * 128 + col0 + 8 * c, d);
    };
    gemm_phase<false>(wv, af, which ? p.wt_nsa_v1 : p.wt_nsa_k1, 2048, 8160, 256, emath, estore, smem, which * 32);
  }
}

DI void phase_nsa_cmp2(const int wv, const Params& p, char* smem) {
  for (int which = 0; which < 2; ++which) {
    APlain af{which ? p.hidv : p.hidk, 128};
    bf16* dst = which ? p.vc : p.kc;
    auto emath = [&](int, int, float&, float&) {};
    auto estore = [&](int row, int col0, int c, u32x4 d) {
      if (col0 == 0) {
        const int kvh = row & 3, bn = row >> 2, b = bn / 255, n = bn - b * 255;
        st16(dst + ((size_t)(b * 4 + kvh) * 256 + n) * 64 + 8 * c, d);
      }
    };
    gemm_phase<false>(wv, af, which ? p.wt_nsa_v2 : p.wt_nsa_k2, 128, 8160, 256, emath, estore, smem, which * 32);
  }
}

DI void nsa_select_item(const int wv, const Params& p, int item, float* impl, const bf16* skc) {
  const int lane = tid() & 63, r = lane & 31, h = lane >> 5;
  const int qt = item & 127, kvh = (item >> 7) & 3, b = item >> 9;
  const int qw = qt * 32, qblk = qw >> 6;
  uint64_t* dst = p.selmask + ((size_t)(b * 4 + kvh) * 4096 + qw);
  if (qblk < 16) { if (h == 0) dst[r] = (2ull << qblk) - 1ull; return; }
  const bf16* qrow = p.Qs + ((size_t)b * 4096 + qw + r) * 1024 + kvh * 256;
  const int qpos = qw + r;
  int nvis = (qpos - 31) >> 4; nvis = nvis < 254 ? nvis : 254;
  int nmaxw = qw >> 4; nmaxw = nmaxw < 254 ? nmaxw : 254;
  const int ntile = (nmaxw >> 5) + 1;
  for (int j = 0; j < 32; ++j) impl[j * 64 + lane] = 0.f;
  for (int g = 0; g < 4; ++g) {
    bf16x8 qf[4];
#pragma unroll
    for (int ks = 0; ks < 4; ++ks) qf[ks] = *(const bf16x8*)(qrow + g * 64 + ks * 16 + h * 8);
    float mg = -1e30f, lg = 0.f;
    for (int tt = 0; tt < ntile; ++tt) {
      f32x16 s;
#pragma unroll
      for (int i = 0; i < 16; ++i) s[i] = 0.f;
#pragma unroll
      for (int ks = 0; ks < 4; ++ks) s = mfma32(*(const bf16x8*)(skc + (tt * 32 + r) * 72 + ks * 16 + h * 8), qf[ks], s);
      float mx = mg;
#pragma unroll
      for (int i = 0; i < 16; ++i) { const int n = tt * 32 + crow(i, h); s[i] = (n <= nvis) ? s[i] : -INFINITY; mx = fmaxf(mx, s[i]); }
      float sum = 0.f;
#pragma unroll
      for (int i = 0; i < 16; ++i) sum += fexp2(s[i] - mx);
      lg = lg * fexp2(mg - mx) + sum; mg = mx;
    }
    {
      float mo = __shfl_xor(mg, 32), lo = __shfl_xor(lg, 32);
      float M = fmaxf(mg, mo);
      float L = lg * fexp2(mg - M) + lo * fexp2(mo - M);
      mg = M; lg = 1.f / L;
    }
    float pending = 0.f;
    for (int tt = 0; tt < ntile; ++tt) {
      f32x16 s;
#pragma unroll
      for (int i = 0; i < 16; ++i) s[i] = 0.f;
#pragma unroll
      for (int ks = 0; ks < 4; ++ks) s = mfma32(*(const bf16x8*)(skc + (tt * 32 + r) * 72 + ks * 16 + h * 8), qf[ks], s);
#pragma unroll
      for (int gq = 0; gq < 4; ++gq) {
        float pe[4];
#pragma unroll
        for (int e = 0; e < 4; ++e) { const int n = tt * 32 + 8 * gq + 4 * h + e; pe[e] = (n <= nvis) ? fexp2(s[4 * gq + e] - mg) * lg : 0.f; }
        const float cy = 0.5f * pe[3];
        const float rc = __shfl_xor(cy, 32);
        const float add = h ? rc : pending;
        pending = rc;
        impl[(4 * tt + gq) * 64 + lane] += pe[0] + pe[1] + pe[2] + cy + add;
      }
    }
  }
  float imp[32];
#pragma unroll
  for (int j = 0; j < 32; ++j) {
    const int bid = 2 * j + h;
    const bool excl = (bid > qblk) || (bid == 0) || (bid == qblk) || (bid == qblk - 1);
    imp[j] = excl ? -3.f : impl[j * 64 + lane];
  }
  uint32_t bits = 0;
  for (int it = 0; it < 13; ++it) {
    float best = imp[0]; int bj = 0;
#pragma unroll
    for (int j = 1; j < 32; ++j) { const bool gt = imp[j] > best; best = gt ? imp[j] : best; bj = gt ? j : bj; }
    const float pb = __shfl_xor(best, 32); const int pj = __shfl_xor(bj, 32);
    const int myid = 2 * bj + h, pid = 2 * pj + (1 - h);
    const bool win = (best > pb) || (best == pb && myid < pid);
#pragma unroll
    for (int j = 0; j < 32; ++j) imp[j] = (win && j == bj) ? -3.f : imp[j];
    bits |= win ? (1u << bj) : 0u;
  }
  uint64_t xm = bits;
  xm = (xm | (xm << 16)) & 0x0000FFFF0000FFFFull;
  xm = (xm | (xm << 8)) & 0x00FF00FF00FF00FFull;
  xm = (xm | (xm << 4)) & 0x0F0F0F0F0F0F0F0Full;
  xm = (xm | (xm << 2)) & 0x3333333333333333ull;
  xm = (xm | (xm << 1)) & 0x5555555555555555ull;
  xm <<= h;
  uint32_t lo = (uint32_t)xm, hi = (uint32_t)(xm >> 32);
  uint32_t plo = __shfl_xor(lo, 32), phi = __shfl_xor(hi, 32);
  uint64_t full = xm | ((uint64_t)phi << 32) | plo;
  full |= 1ull | (1ull << qblk) | (1ull << (qblk - 1));
  if (h == 0) dst[r] = full;
}

DI void phase_nsa_select(const int wv, const Params& p, char* smem) {
  const int t = tid(), wave = __builtin_amdgcn_readfirstlane(t >> 6);
  float* impl = (float*)smem + wave * 2048;
  bf16* skc = (bf16*)(smem + NW * 8192);
  for (int bq = blockIdx.x; bq < 4096 / NW; bq += gridDim.x) {
    const int bi = ((bq / (int)gridDim.x) & 1) ? (bq ^ 15) : bq;
    const int item0 = bi * NW;
    const int kvh = (item0 >> 7) & 3, b = item0 >> 9;
    const bf16* kcg = p.kc + (size_t)(b * 4 + kvh) * 256 * 64;
    __syncthreads();
    for (int c = t; c < 256 * 8; c += NT) { const int row = c >> 3, ch = c & 7; *(u32x4*)(skc + row * 72 + ch * 8) = *(const u32x4*)(kcg + row * 64 + ch * 8); }
    __syncthreads();
    nsa_select_item(wv, p, item0 + wave, impl, skc);
  }
}

DI void phase_nsa_attn(const int wv, const Params& p, char* smem) {
  const int t = tid(), lane = t & 63, wave = __builtin_amdgcn_readfirstlane(t >> 6), r = lane & 31, h = lane >> 5;
  for (int item = blockIdx.x; item < 2048; item += gridDim.x) {
    int qt, bk; item_map(item, 32, 64, qt, bk);
    const int b = bk >> 2, kvh = bk & 3, hd = kvh * 4 + (wave >> 1);
    const int q0 = qt * 64, qw = q0 + 32 * (wave & 1);
    const size_t tok = (size_t)b * 4096 + qw + r;
    bf16x8 qf[4];
#pragma unroll
    for (int ks = 0; ks < 4; ++ks) qf[ks] = *(const bf16x8*)(p.Qs + tok * 1024 + hd * 64 + ks * 16 + h * 8);
    const float g0 = (float)p.gb[tok * 48 + hd * 3 + 0], g1 = (float)p.gb[tok * 48 + hd * 3 + 1], g2 = (float)p.gb[tok * 48 + hd * 3 + 2];
    const uint64_t selm = p.selmask[(size_t)(b * 4 + kvh) * 4096 + qw + r];
    f32x16 oacc[2], ot[2]; float m, l;
    attn_core<64, 64, M_CMP, 64>(wv, qf, p.kc + (size_t)(b * 4 + kvh) * 256 * 64, 64, p.vc + (size_t)(b * 4 + kvh) * 256 * 64, 64, q0, 64, qw, 0, 0ull, ot, m, l, smem);
    {
      const float w = (l > 0.f) ? g0 / l : 0.f;
#pragma unroll
      for (int d = 0; d < 2; ++d)
#pragma unroll
        for (int i = 0; i < 16; ++i) oacc[d][i] = ot[d][i] * w;
    }
    attn_core<64, 64, M_SEL, 64>(wv, qf, p.kslc + (size_t)b * 4096 * 256 + kvh * 64, 256, p.vslc + (size_t)b * 4096 * 256 + kvh * 64, 256, q0, 64, qw, 0, selm, ot, m, l, smem);
    {
      const float w = g1 / l;
#pragma unroll
      for (int d = 0; d < 2; ++d)
#pragma unroll
        for (int i = 0; i < 16; ++i) oacc[d][i] += ot[d][i] * w;
    }
    attn_core<64, 64, M_WINDOW, 64>(wv, qf, p.kwin + (size_t)b * 4096 * 256 + kvh * 64, 256, p.vwin + (size_t)b * 4096 * 256 + kvh * 64, 256, q0, 64, qw, 512, 0ull, ot, m, l, smem);
    {
      const float w = g2 / l;
#pragma unroll
      for (int d = 0; d < 2; ++d)
#pragma unroll
        for (int i = 0; i < 16; ++i) oacc[d][i] += ot[d][i] * w;
    }
    attn_store<64>(wv, oacc, 1.f, p.sg, p.h, (size_t)b * 4096 + qw, hd * 64, smem);
  }
}

#define XB_TMO      128
#define XB_XCNT(j)  (256  + 64 * (j))
#define XB_XSUB(j)  (1280 + 64 * (j))
#define XB_XGEN(j)  (2304 + 64 * (j))
#define XB_TOP      3328
#define XB_TOPGEN   3392
#define XCD_BAR_WORDS 3456
#define XB_SPIN_CAP (1u << 22)
#define LAS __attribute__((address_space(3)))
DI unsigned xb_ld(unsigned* p)              { return __hip_atomic_load(p, __ATOMIC_RELAXED, __HIP_MEMORY_SCOPE_AGENT); }
DI unsigned xb_add(unsigned* p, unsigned v) { return __hip_atomic_fetch_add(p, v, __ATOMIC_RELAXED, __HIP_MEMORY_SCOPE_AGENT); }
DI unsigned xb_xcc_id() { return (unsigned)__builtin_amdgcn_s_getreg((3 << 11) | 20) & 0xFu; }
#define XB_SPIN(cond, bar) do { unsigned _sp = 0; while (cond) { __builtin_amdgcn_s_sleep(1); \
    if ((++_sp & 255u) == 0u) { if (xb_ld(&(bar)[XB_TMO])) break; if (_sp > XB_SPIN_CAP) { atomicAdd(&(bar)[XB_TMO], 1u); break; } } } } while (0)
struct XcdBarrier { unsigned* bar; unsigned x; volatile LAS unsigned* st; int w0; };
DI bool xb_leader(int w0) { return w0 && __builtin_amdgcn_mbcnt_hi(~0u, __builtin_amdgcn_mbcnt_lo(~0u, 0u)) == 0; }
DI XcdBarrier xcd_barrier_post(unsigned* bar, volatile LAS unsigned* st, int w0) {
  XcdBarrier b; b.bar = bar; b.x = xb_xcc_id(); b.st = st; b.w0 = w0;
  if (xb_leader(w0)) (void)xb_add(&bar[XB_XCNT(b.x)], 1u);
  return b;
}
DI void xcd_barrier_complete(unsigned* bar, unsigned x, unsigned& nloc, unsigned& nx) {
  const unsigned G = gridDim.x * gridDim.y * gridDim.z;
  unsigned sum, cnt, mine, sp = 0u;
  for (;;) {
    sum = 0u; cnt = 0u; mine = 0u;
#pragma unroll
    for (unsigned j = 0; j < 16; ++j) { const unsigned c = xb_ld(&bar[XB_XCNT(j)]); sum += c; cnt += (c > 0u) ? 1u : 0u; mine = (j == x) ? c : mine; }
    if (sum == G) break;
    __builtin_amdgcn_s_sleep(1);
    if ((++sp & 255u) == 0u) { if (xb_ld(&bar[XB_TMO])) break; if (sp > XB_SPIN_CAP) { atomicAdd(&bar[XB_TMO], 1u); break; } }
  }
  nloc = mine > 0u ? mine : 1u; nx = cnt > 0u ? cnt : 1u;
}
DI void xcd_barrier(const XcdBarrier& b) {
  asm volatile("s_waitcnt vmcnt(0)" ::: "memory");
  __syncthreads();
  if (xb_leader(b.w0)) {
    unsigned* bar = b.bar;
    __builtin_amdgcn_s_waitcnt(0);
    unsigned nloc = b.st[0], nx = b.st[1];
    if (nloc == 0u) { xcd_barrier_complete(bar, b.x, nloc, nx); b.st[0] = nloc; b.st[1] = nx; }
    const unsigned old = xb_add(&bar[XB_XSUB(b.x)], 1u);
    const unsigned gen = old / nloc;
    if (old + 1u == (gen + 1u) * nloc) {
      __builtin_amdgcn_fence(__ATOMIC_RELEASE, "agent");
      asm volatile("s_waitcnt vmcnt(0)" ::: "memory");
      const unsigned og = xb_add(&bar[XB_TOP], 1u);
      const unsigned tg = og / nx;
      if (og + 1u == (tg + 1u) * nx) xb_add(&bar[XB_TOPGEN], 1u);
      else XB_SPIN(xb_ld(&bar[XB_TOPGEN]) == tg, bar);
      __builtin_amdgcn_fence(__ATOMIC_ACQUIRE, "agent");
      xb_add(&bar[XB_XGEN(b.x)], 1u);
      asm volatile("s_waitcnt vmcnt(0)" ::: "memory");
    } else {
      XB_SPIN(xb_ld(&bar[XB_XGEN(b.x)]) == gen, bar);
      __builtin_amdgcn_fence(__ATOMIC_ACQUIRE, "agent");
      asm volatile("s_waitcnt vmcnt(0)" ::: "memory");
    }
  }
  __syncthreads();
}

constexpr int NPHASE = 23;
#ifndef ONLY_PH
#define ONLY_PH -1
#endif
#ifndef DUP_MASK
#define DUP_MASK 0u
#endif
#define PHASE(i, call)                                                        \
  if ((ONLY_PH < 0 || ONLY_PH == (i)) && ph_begin <= (i) && (i) < ph_end) {   \
    call;                                                                     \
    if ((DUP_MASK >> (i)) & 1u) { __syncthreads(); call; }                    \
    if ((i) + 1 < ph_end) xcd_barrier(xb);                                    \
  }

__global__ void __launch_bounds__(NT, 2) mega(Params p_arg, int ph_begin, int ph_end) {
  __shared__ __attribute__((aligned(16))) char smem[SMEM_BYTES];
  cg::grid_group grid = cg::this_grid();
  const Params& p = *(const Params*)__builtin_amdgcn_kernarg_segment_ptr();
  const int wv = __builtin_amdgcn_readfirstlane((int)threadIdx.x >> 6);
  __shared__ __attribute__((aligned(16))) unsigned xb_words[4];
  if (threadIdx.x == 0) { xb_words[0] = 0u; xb_words[1] = 0u; xb_words[2] = 0u; xb_words[3] = 0u; }
  __syncthreads();
  if (ph_begin < 0) grid.sync();
  XcdBarrier xb = xcd_barrier_post(p.bar, (volatile LAS unsigned*)xb_words, wv == 0);
  PHASE(0, phase_prep(wv, p, smem))
  PHASE(1, (phase_norm(wv, p, 0, p.x), phase_prep_b(wv, p, smem)))
  PHASE(2, phase_mla_inproj(wv, p, 0, smem))
  PHASE(3, phase_mla_qkvb(wv, p, 0, smem))
  PHASE(4, phase_mla_attn(wv, p, smem))
  PHASE(5, phase_outproj(wv, p, 0, p.wt_mla_out[0], p.x, smem))
  PHASE(6, phase_norm(wv, p, 1, p.out))
  PHASE(7, phase_swa_inproj(wv, p, smem))
  PHASE(8, phase_swa_attn(wv, p, smem))
  PHASE(9, phase_outproj(wv, p, 1, p.wt_swa_out, p.out, smem))
  PHASE(10, phase_norm(wv, p, 2, p.out))
  PHASE(11, phase_nsa_inproj(wv, p, smem))
  PHASE(12, phase_nsa_cmp1(wv, p, smem))
  PHASE(13, phase_nsa_cmp2(wv, p, smem))
  PHASE(14, phase_nsa_select(wv, p, smem))
  PHASE(15, phase_nsa_attn(wv, p, smem))
  PHASE(16, phase_outproj(wv, p, 2, p.wt_nsa_out, p.out, smem))
  PHASE(17, phase_norm(wv, p, 3, p.out))
  PHASE(18, phase_mla_inproj(wv, p, 1, smem))
  PHASE(19, phase_mla_qkvb(wv, p, 1, smem))
  PHASE(20, phase_mla_attn(wv, p, smem))
  PHASE(21, phase_outproj(wv, p, 3, p.wt_mla_out[1], p.out, smem))
  PHASE(22, phase_final(wv, p))
}

#ifndef N_LAUNCH_MODE
#define N_LAUNCH_MODE 0
#endif

extern "C" void kernel_launch(void* const* d_in, const int* in_sizes, int n_in,
                              void* d_out, int out_size, void* d_ws, size_t ws_size,
                              hipStream_t stream) {
  static int grid_blocks = 0;
  if (!grid_blocks) {
    int dev = 0, cus = 0, per_cu = 0;
    (void)hipGetDevice(&dev);
    (void)hipDeviceGetAttribute(&cus, hipDeviceAttributeMultiprocessorCount, dev);
    (void)hipOccupancyMaxActiveBlocksPerMultiprocessor(&per_cu, mega, NT, 0);
    if (per_cu > 1) per_cu = 1;
    if (per_cu < 1) per_cu = 1;
    grid_blocks = 256 * per_cu;
    if (cus < 256) grid_blocks = 256;
  }
  Params p{};
  p.x = (const float*)d_in[0]; p.c = (const float*)d_in[1]; p.pos = (const int*)d_in[2];
  p.norm_g = (const float*)d_in[3]; p.ada_w = (const float*)d_in[4]; p.ada_b = (const float*)d_in[5];
  p.mla_w_in = (const float*)d_in[6]; p.mla_qg = (const float*)d_in[7]; p.mla_kvg = (const float*)d_in[8];
  p.mla_wqb = (const float*)d_in[9]; p.mla_wkvb = (const float*)d_in[10]; p.mla_wout = (const float*)d_in[11];
  p.swa_w_in = (const float*)d_in[12]; p.swa_sinks = (const float*)d_in[13]; p.swa_wout = (const float*)d_in[14];
  p.nsa_w_in = (const float*)d_in[15]; p.nsa_pos = (const float*)d_in[16]; p.nsa_k1 = (const float*)d_in[17];
  p.nsa_k2 = (const float*)d_in[18]; p.nsa_v1 = (const float*)d_in[19]; p.nsa_v2 = (const float*)d_in[20];
  p.nsa_wout = (const float*)d_in[21]; p.final_g = (const float*)d_in[22];
  p.out = (float*)d_out;
  char* w = (char*)d_ws; size_t off = 0;
  auto alloc = [&](size_t bytes) { void* r = w + off; off += (bytes + 255) & ~(size_t)255; return r; };
  p.bar = (unsigned*)alloc(16384);
  p.ssq_q = (float*)alloc((size_t)T * 4);
  p.ssq_kv = (float*)alloc((size_t)T * 4);
  for (int j = 0; j < 2; ++j) {
    p.wt_mla_in[j] = (bf16*)alloc((size_t)1536 * 1024 * 2);
    p.wt_mla_qb[j] = (bf16*)alloc((size_t)1536 * 256 * 2);
    p.wt_mla_kvb[j] = (bf16*)alloc((size_t)2048 * 128 * 2);
    p.wt_mla_out[j] = (bf16*)alloc((size_t)1024 * 1024 * 2);
  }
  p.wt_swa_in = (bf16*)alloc((size_t)2304 * 1024 * 2);
  p.wt_swa_out = (bf16*)alloc((size_t)1024 * 1024 * 2);
  p.wt_nsa_in = (bf16*)alloc((size_t)3840 * 1024 * 2);
  p.wt_nsa_k1 = (bf16*)alloc((size_t)256 * 2048 * 2);
  p.wt_nsa_k2 = (bf16*)alloc((size_t)256 * 128 * 2);
  p.wt_nsa_v1 = (bf16*)alloc((size_t)256 * 2048 * 2);
  p.wt_nsa_v2 = (bf16*)alloc((size_t)256 * 128 * 2);
  p.wt_nsa_out = (bf16*)alloc((size_t)1024 * 1024 * 2);
  p.mod = (float*)alloc((size_t)4 * 8 * 3072 * 4);
  p.rope = (float2*)alloc((size_t)T * 32 * 8);
  p.posbp = (float*)alloc((size_t)2 * 16 * 128 * 4);
  p.h = (bf16*)alloc((size_t)T * 1024 * 2);
  p.sg = (bf16*)alloc((size_t)T * 1024 * 2);
  const size_t region = off;
  p.qa = (bf16*)alloc((size_t)T * 256 * 2);
  p.kva = (bf16*)alloc((size_t)T * 128 * 2);
  p.Qm = (bf16*)alloc((size_t)T * 8 * 192 * 2);
  p.Km = (bf16*)alloc((size_t)T * 8 * 192 * 2);
  p.Vm = (bf16*)alloc((size_t)T * 8 * 128 * 2);
  off = region;
  p.Qs = (bf16*)alloc((size_t)T * 1024 * 2);
  p.Ks = (bf16*)alloc((size_t)T * 128 * 2);
  p.Vs = (bf16*)alloc((size_t)T * 128 * 2);
  p.kcmp = (bf16*)alloc((size_t)T * 256 * 2);
  p.vcmp = (bf16*)alloc((size_t)T * 256 * 2);
  p.kslc = (bf16*)alloc((size_t)T * 256 * 2);
  p.vslc = (bf16*)alloc((size_t)T * 256 * 2);
  p.kwin = (bf16*)alloc((size_t)T * 256 * 2);
  p.vwin = (bf16*)alloc((size_t)T * 256 * 2);
  p.gb = (bf16*)alloc((size_t)T * 48 * 2);
  p.hidk = (bf16*)alloc((size_t)8192 * 128 * 2);
  p.hidv = (bf16*)alloc((size_t)8192 * 128 * 2);
  p.kc = (bf16*)alloc((size_t)32 * 256 * 64 * 2);
  p.vc = (bf16*)alloc((size_t)32 * 256 * 64 * 2);
  p.selmask = (uint64_t*)alloc((size_t)32 * 4096 * 8);

#if N_LAUNCH_MODE == 0
  (void)hipMemsetAsync(p.bar, 0, 16384, stream);
  int b0 = 0, b1 = NPHASE;
  void* args[] = {&p, &b0, &b1};
  hipError_t e = hipLaunchCooperativeKernel((void*)mega, dim3(grid_blocks), dim3(NT), args, 0, stream);
  if (e != hipSuccess) fprintf(stderr, "cooperative launch failed: %s (grid %d)\n", hipGetErrorString(e), grid_blocks);
#else
  for (int ph = 0; ph < NPHASE; ++ph) hipLaunchKernelGGL(mega, dim3(grid_blocks), dim3(NT), 0, stream, p, ph, ph + 1);
#endif
}
```
